# Optimizing an MI355X kernel written in HIP

```python
import math
import jax
import jax.numpy as jnp
from jax import lax
import numpy as np

D_MODEL = 1024
BATCH = 2
SEQ = 8192
DEPTH = 2
DEC_BATCH = 4
DEC_SEQ = 4096
PAST_LEN = 128

GRID_W = 64
N_MEM = 256
D_FF = 2816
HEAD_DIM = 64
BRANCH_W = 256
N_BRANCH = 5
SSM_P = 16
SSM_G = BRANCH_W // SSM_P
SSM_N = 64
SWA_HQ = 4
SWA_HKV = 2
SWA_WIN = 128
SWA_BLK = 128
T5_BUCKETS = 32
T5_MAX_DIST = 128
NA_H = 4
NA_KH = 8
NA_KW = 16
MLA_H = 4
MLA_Q_RANK = 192
MLA_KV_RANK = 128
MLA_NOPE = 64
MLA_ROPE = 32
MLA_V = 64
MLA_BLK = 128
ROPE_THETA = 10000.0
MEM_H = 4
EPS = 1e-6
NEG = -1e30
IN_WIDTHS = (BRANCH_W,
             SWA_HQ * HEAD_DIM, SWA_HKV * HEAD_DIM, SWA_HKV * HEAD_DIM,
             NA_H * HEAD_DIM, NA_H * HEAD_DIM, NA_H * HEAD_DIM,
             MLA_Q_RANK, MLA_KV_RANK, MLA_ROPE,
             MEM_H * HEAD_DIM,
             N_BRANCH * D_MODEL)
D_IN = sum(IN_WIDTHS)

kernel_name = 'hybrid_bidir_encoder_two_groups'

F32 = jnp.float32


def _rmsnorm(x, g):
    xf = x.astype(F32)
    y = xf * lax.rsqrt(jnp.mean(xf * xf, axis=-1, keepdims=True) + EPS)
    return (y * g.astype(F32)).astype(x.dtype)


def _swiglu(x, w_gate, w_up, w_down):
    return (jax.nn.silu(x @ w_gate) * (x @ w_up)) @ w_down


def _cplx_combine(e1, e2):
    a1r, a1i, b1r, b1i = e1
    a2r, a2i, b2r, b2i = e2
    return (a2r * a1r - a2i * a1i,
            a2r * a1i + a2i * a1r,
            a2r * b1r - a2i * b1i + b2r,
            a2r * b1i + a2i * b1r + b2i)


def _s5(u, lam_re, lam_im, log_step, b_re, b_im, c_re, c_im, d_skip, w_glu):
    Bsz, S, _ = u.shape
    uf = u.astype(F32).reshape(Bsz, S, SSM_G, SSM_P)
    lr = lam_re.astype(F32)
    li = lam_im.astype(F32)
    dt = jnp.exp(log_step.astype(F32))[..., None]
    mag = jnp.exp(lr * dt)
    a_re = mag * jnp.cos(li * dt)
    a_im = mag * jnp.sin(li * dt)
    den = lr * lr + li * li
    xr = a_re - 1.0
    k_re = (xr * lr + a_im * li) / den
    k_im = (a_im * lr - xr * li) / den
    br = b_re.astype(F32)
    bi = b_im.astype(F32)
    bb_re = k_re[..., None] * br - k_im[..., None] * bi
    bb_im = k_re[..., None] * bi + k_im[..., None] * br
    cr = c_re.astype(F32)
    ci = c_im.astype(F32)
    y = d_skip.astype(F32).reshape(SSM_G, SSM_P) * uf
    for dirn, rev in ((0, False), (1, True)):
        bu_re = jnp.einsum('bsgp,gnp->bsgn', uf, bb_re[dirn])
        bu_im = jnp.einsum('bsgp,gnp->bsgn', uf, bb_im[dirn])
        ar = jnp.broadcast_to(a_re[dirn], bu_re.shape)
        ai = jnp.broadcast_to(a_im[dirn], bu_re.shape)
        _, _, st_re, st_im = lax.associative_scan(_cplx_combine, (ar, ai, bu_re, bu_im),
                                                  reverse=rev, axis=1)
        y = y + jnp.einsum('bsgn,gpn->bsgp', st_re, cr[dirn]) \
              - jnp.einsum('bsgn,gpn->bsgp', st_im, ci[dirn])
    g = jax.nn.gelu(y.reshape(Bsz, S, BRANCH_W)).astype(u.dtype)
    return g * jax.nn.sigmoid(g @ w_glu)


def _t5_bucket(rel):
    nb = T5_BUCKETS // 2
    max_exact = nb // 2
    ret = (rel > 0).astype(jnp.int32) * nb
    n = jnp.abs(rel)
    nf = jnp.maximum(n, 1).astype(F32)
    large = max_exact + (jnp.log(nf / max_exact) / math.log(T5_MAX_DIST / max_exact)
                         * (nb - max_exact)).astype(jnp.int32)
    large = jnp.minimum(large, nb - 1)
    return ret + jnp.where(n < max_exact, n, large)


def _swa(q, k, v, sink, t5_bias):
    Bsz, S, _ = q.shape
    nb = S // SWA_BLK
    rep = SWA_HQ // SWA_HKV
    qb = q.reshape(Bsz, nb, SWA_BLK, SWA_HKV, rep, HEAD_DIM)
    pad = ((0, 0), (SWA_BLK, SWA_BLK), (0, 0), (0, 0))
    kp = jnp.pad(k.reshape(Bsz, S, SWA_HKV, HEAD_DIM), pad).reshape(Bsz, nb + 2, SWA_BLK, SWA_HKV, HEAD_DIM)
    vp = jnp.pad(v.reshape(Bsz, S, SWA_HKV, HEAD_DIM), pad).reshape(Bsz, nb + 2, SWA_BLK, SWA_HKV, HEAD_DIM)
    kb = jnp.concatenate([kp[:, :-2], kp[:, 1:-1], kp[:, 2:]], axis=2)
    vb = jnp.concatenate([vp[:, :-2], vp[:, 1:-1], vp[:, 2:]], axis=2)
    logits = jnp.einsum('bnqgrd,bnkgd->bngrqk', qb, kb,
                        preferred_element_type=F32) * (HEAD_DIM ** -0.5)
    qi = jnp.arange(SWA_BLK)[:, None]
    kj = jnp.arange(3 * SWA_BLK)[None, :]
    rel = kj - SWA_BLK - qi
    bias = t5_bias.astype(F32)[_t5_bucket(rel)]
    bias = bias.transpose(2, 0, 1).reshape(SWA_HKV, rep, SWA_BLK, 3 * SWA_BLK)
    kpos = jnp.arange(nb)[:, None] * SWA_BLK + kj - SWA_BLK
    valid = (jnp.abs(rel) <= SWA_WIN)[None] & ((kpos >= 0) & (kpos < S))[:, None, :]
    logits = jnp.where(valid[None, :, None, None], logits + bias, NEG)
    sink_col = jnp.broadcast_to(sink.astype(F32).reshape(SWA_HKV, rep)[None, None, :, :, None, None],
                                logits.shape[:-1] + (1,))
    p = jax.nn.softmax(jnp.concatenate([logits, sink_col], axis=-1), axis=-1)[..., :-1]
    out = jnp.einsum('bngrqk,bnkgd->bnqgrd', p.astype(v.dtype), vb)
    return out.reshape(Bsz, S, SWA_HQ * HEAD_DIM)


def _na(q, k, v, rpb):
    Bsz, S, _ = q.shape
    rows = S // GRID_W
    kh = min(NA_KH, rows)
    kw = NA_KW
    qg = q.reshape(Bsz, rows, GRID_W, NA_H, HEAD_DIM)
    kg = k.reshape(Bsz, rows, GRID_W, NA_H, HEAD_DIM)
    vg = v.reshape(Bsz, rows, GRID_W, NA_H, HEAD_DIM)
    cols = jnp.arange(GRID_W)
    cs = jnp.clip(cols - kw // 2, 0, GRID_W - kw)
    col_idx = cs[:, None] + jnp.arange(kw)[None, :]
    dc_idx = col_idx - cols[:, None] + (NA_KW - 1)
    rpb_f = rpb.astype(F32)

    def row_fn(args):
        r, q_row = args
        rs = jnp.clip(r - kh // 2, 0, rows - kh)
        k_rows = lax.dynamic_slice_in_dim(kg, rs, kh, axis=1)
        v_rows = lax.dynamic_slice_in_dim(vg, rs, kh, axis=1)
        k_win = k_rows[:, :, col_idx]
        v_win = v_rows[:, :, col_idx]
        logits = jnp.einsum('bchd,brckhd->bhcrk', q_row, k_win,
                            preferred_element_type=F32) * (HEAD_DIM ** -0.5)
        dr_idx = rs + jnp.arange(kh) - r + (NA_KH - 1)
        bias = rpb_f[:, dr_idx[None, :, None], dc_idx[:, None, :]]
        logits = logits + bias[None]
        p = jax.nn.softmax(logits.reshape(Bsz, NA_H, GRID_W, kh * kw), axis=-1)
        p = p.reshape(Bsz, NA_H, GRID_W, kh, kw).astype(v.dtype)
        return jnp.einsum('bhcrk,brckhd->bchd', p, v_win)

    out = lax.map(row_fn, (jnp.arange(rows), qg.transpose(1, 0, 2, 3, 4)))
    return out.transpose(1, 0, 2, 3, 4).reshape(Bsz, S, NA_H * HEAD_DIM)


def _rope(x, pos):
    half = x.shape[-1] // 2
    inv = ROPE_THETA ** (-jnp.arange(half, dtype=F32) / half)
    ang = pos.astype(F32)[:, None] * inv[None, :]
    cos = jnp.cos(ang)[:, None, :]
    sin = jnp.sin(ang)[:, None, :]
    x1 = x[..., :half].astype(F32)
    x2 = x[..., half:].astype(F32)
    return jnp.concatenate([x1 * cos - x2 * sin, x1 * sin + x2 * cos], axis=-1).astype(x.dtype)


def _mla(c_q, c_kv, k_rope, q_norm, w_q_up, kv_norm, w_kv_up):
    Bsz, S, _ = c_q.shape
    dq = MLA_NOPE + MLA_ROPE
    pos = jnp.arange(S)
    q = (_rmsnorm(c_q, q_norm) @ w_q_up).reshape(Bsz, S, MLA_H, dq)
    kv = (_rmsnorm(c_kv, kv_norm) @ w_kv_up).reshape(Bsz, S, MLA_H, MLA_NOPE + MLA_V)
    q = jnp.concatenate([q[..., :MLA_NOPE], _rope(q[..., MLA_NOPE:], pos)], axis=-1)
    kr = jnp.broadcast_to(_rope(k_rope[:, :, None, :], pos), (Bsz, S, MLA_H, MLA_ROPE))
    k = jnp.concatenate([kv[..., :MLA_NOPE], kr], axis=-1)
    v = kv[..., MLA_NOPE:]
    nb = S // MLA_BLK
    qb = q.reshape(Bsz, nb, MLA_BLK, MLA_H, dq).transpose(1, 0, 2, 3, 4)

    def blk(q_blk):
        logits = jnp.einsum('bqhd,bkhd->bhqk', q_blk, k, preferred_element_type=F32) * (dq ** -0.5)
        p = jax.nn.softmax(logits, axis=-1).astype(v.dtype)
        return jnp.einsum('bhqk,bkhd->bqhd', p, v)

    out = lax.map(blk, qb)
    return out.transpose(1, 0, 2, 3, 4).reshape(Bsz, S, MLA_H * MLA_V)


def _mem_attn(q, mem, mem_norm, w_mem_kv):
    Bsz, S, _ = q.shape
    kv = _rmsnorm(mem, mem_norm) @ w_mem_kv
    k, v = jnp.split(kv, 2, axis=-1)
    k = k.reshape(Bsz, -1, MEM_H, HEAD_DIM)
    v = v.reshape(Bsz, -1, MEM_H, HEAD_DIM)
    qh = q.reshape(Bsz, S, MEM_H, HEAD_DIM)
    logits = jnp.einsum('bshd,bmhd->bhsm', qh, k, preferred_element_type=F32) * (HEAD_DIM ** -0.5)
    p = jax.nn.softmax(logits, axis=-1).astype(v.dtype)
    return jnp.einsum('bhsm,bmhd->bshd', p, v).reshape(Bsz, S, MEM_H * HEAD_DIM)


def _trunk(x, mem, w):
    Bsz, S, _ = x.shape
    offs = np.cumsum(IN_WIDTHS)[:-1].tolist()
    h = x
    for l in range(DEPTH):
        h = h + 0.5 * _swiglu(_rmsnorm(h, w['ffn1_norm'][l]), w['ffn1_w_gate'][l],
                              w['ffn1_w_up'][l], w['ffn1_w_down'][l])
        u = _rmsnorm(h, w['mix_norm'][l])
        (a_in, swa_q, swa_k, swa_v, na_q, na_k, na_v, c_q, c_kv, k_rope, mem_q,
         gate_logits) = jnp.split(u @ w['w_in'][l], offs, axis=-1)
        branches = (
            _s5(a_in, w['ssm_lam_re'][l], w['ssm_lam_im'][l], w['ssm_log_step'][l],
                w['ssm_b_re'][l], w['ssm_b_im'][l], w['ssm_c_re'][l], w['ssm_c_im'][l],
                w['ssm_d'][l], w['ssm_w_glu'][l]),
            _swa(swa_q, swa_k, swa_v, w['swa_sink'][l], w['t5_bias']),
            _na(na_q, na_k, na_v, w['na_rpb'][l]),
            _mla(c_q, c_kv, k_rope, w['mla_q_norm'][l], w['mla_w_q_up'][l],
                 w['mla_kv_norm'][l], w['mla_w_kv_up'][l]),
            _mem_attn(mem_q, mem, w['mem_norm'][l], w['mem_w_kv'][l]),
        )
        gates = jax.nn.sigmoid(gate_logits.astype(F32)).astype(h.dtype).reshape(Bsz, S, N_BRANCH, D_MODEL)
        merged = gates[:, :, 0] * (branches[0] @ w['w_branch'][l, 0])
        for n in range(1, N_BRANCH):
            merged = merged + gates[:, :, n] * (branches[n] @ w['w_branch'][l, n])
        h = h + merged @ w['w_out'][l]
        h = h + 0.5 * _swiglu(_rmsnorm(h, w['ffn2_norm'][l]), w['ffn2_w_gate'][l],
                              w['ffn2_w_up'][l], w['ffn2_w_down'][l])
    return _rmsnorm(h, w['final_norm'])


def setup_inputs(seed: int = 0) -> dict:
    key = jax.random.key(seed)
    ks = iter(jax.random.split(key, 48))

    def nrm(shape, scale):
        return jax.random.normal(next(ks), shape, F32) * scale

    def gain(shape):
        return 1.0 + 0.01 * jax.random.normal(next(ks), shape, F32)

    L, G, N, P = DEPTH, SSM_G, SSM_N, SSM_P
    return {
        'x_prompt': nrm((BATCH, SEQ, D_MODEL), 1.0),
        'x_sample': nrm((DEC_BATCH, DEC_SEQ, D_MODEL), 1.0),
        'mem_prompt': nrm((BATCH, N_MEM, D_MODEL), 1.0),
        'mem_sample': nrm((DEC_BATCH, N_MEM, D_MODEL), 1.0),
        'ffn1_norm': gain((L, D_MODEL)),
        'ffn1_w_gate': nrm((L, D_MODEL, D_FF), D_MODEL ** -0.5),
        'ffn1_w_up': nrm((L, D_MODEL, D_FF), D_MODEL ** -0.5),
        'ffn1_w_down': nrm((L, D_FF, D_MODEL), D_FF ** -0.5),
        'mix_norm': gain((L, D_MODEL)),
        'w_in': nrm((L, D_MODEL, D_IN), D_MODEL ** -0.5),
        'ssm_lam_re': -0.5 + nrm((L, 2, G, N), 0.01),
        'ssm_lam_im': jnp.pi * jnp.arange(N, dtype=F32) + nrm((L, 2, G, N), 0.01),
        'ssm_log_step': jax.random.uniform(next(ks), (L, 2, G), F32, math.log(1e-3), math.log(1e-1)),
        'ssm_b_re': nrm((L, 2, G, N, P), (2 * P) ** -0.5),
        'ssm_b_im': nrm((L, 2, G, N, P), (2 * P) ** -0.5),
        'ssm_c_re': nrm((L, 2, G, P, N), (2 * N) ** -0.5),
        'ssm_c_im': nrm((L, 2, G, P, N), (2 * N) ** -0.5),
        'ssm_d': nrm((L, BRANCH_W), 1.0),
        'ssm_w_glu': nrm((L, BRANCH_W, BRANCH_W), BRANCH_W ** -0.5),
        'swa_sink': nrm((L, SWA_HQ), 0.5),
        't5_bias': nrm((T5_BUCKETS, SWA_HQ), 0.1),
        'na_rpb': nrm((L, NA_H, 2 * NA_KH - 1, 2 * NA_KW - 1), 0.02),
        'mla_q_norm': gain((L, MLA_Q_RANK)),
        'mla_w_q_up': nrm((L, MLA_Q_RANK, MLA_H * (MLA_NOPE + MLA_ROPE)), MLA_Q_RANK ** -0.5),
        'mla_kv_norm': gain((L, MLA_KV_RANK)),
        'mla_w_kv_up': nrm((L, MLA_KV_RANK, MLA_H * (MLA_NOPE + MLA_V)), MLA_KV_RANK ** -0.5),
        'mem_norm': gain((L, D_MODEL)),
        'mem_w_kv': nrm((L, D_MODEL, 2 * MEM_H * HEAD_DIM), D_MODEL ** -0.5),
        'w_branch': nrm((L, N_BRANCH, BRANCH_W, D_MODEL), BRANCH_W ** -0.5),
        'w_out': nrm((L, D_MODEL, D_MODEL), D_MODEL ** -0.5),
        'ffn2_norm': gain((L, D_MODEL)),
        'ffn2_w_gate': nrm((L, D_MODEL, D_FF), D_MODEL ** -0.5),
        'ffn2_w_up': nrm((L, D_MODEL, D_FF), D_MODEL ** -0.5),
        'ffn2_w_down': nrm((L, D_FF, D_MODEL), D_FF ** -0.5),
        'final_norm': gain((D_MODEL,)),
    }


def reference(x_prompt, x_sample, mem_prompt, mem_sample,
              ffn1_norm, ffn1_w_gate, ffn1_w_up, ffn1_w_down,
              mix_norm, w_in,
              ssm_lam_re, ssm_lam_im, ssm_log_step, ssm_b_re, ssm_b_im, ssm_c_re, ssm_c_im,
              ssm_d, ssm_w_glu,
              swa_sink, t5_bias, na_rpb,
              mla_q_norm, mla_w_q_up, mla_kv_norm, mla_w_kv_up,
              mem_norm, mem_w_kv, w_branch, w_out,
              ffn2_norm, ffn2_w_gate, ffn2_w_up, ffn2_w_down,
              final_norm):
    w = dict(ffn1_norm=ffn1_norm, ffn1_w_gate=ffn1_w_gate, ffn1_w_up=ffn1_w_up, ffn1_w_down=ffn1_w_down,
             mix_norm=mix_norm, w_in=w_in,
             ssm_lam_re=ssm_lam_re, ssm_lam_im=ssm_lam_im, ssm_log_step=ssm_log_step,
             ssm_b_re=ssm_b_re, ssm_b_im=ssm_b_im, ssm_c_re=ssm_c_re, ssm_c_im=ssm_c_im,
             ssm_d=ssm_d, ssm_w_glu=ssm_w_glu,
             swa_sink=swa_sink, t5_bias=t5_bias, na_rpb=na_rpb,
             mla_q_norm=mla_q_norm, mla_w_q_up=mla_w_q_up, mla_kv_norm=mla_kv_norm, mla_w_kv_up=mla_w_kv_up,
             mem_norm=mem_norm, mem_w_kv=mem_w_kv, w_branch=w_branch, w_out=w_out,
             ffn2_norm=ffn2_norm, ffn2_w_gate=ffn2_w_gate, ffn2_w_up=ffn2_w_up, ffn2_w_down=ffn2_w_down,
             final_norm=final_norm)
    y_prompt = _trunk(x_prompt, mem_prompt, w)
    y_sample = _trunk(x_sample, mem_sample, w)
    return (y_prompt, y_sample)
```

```cpp
#include <hip/hip_runtime.h>
#include <hip/hip_cooperative_groups.h>
#include <cstdio>
#include <cstdint>
namespace cg = cooperative_groups;

#ifndef PROBE_PH
#define PROBE_PH 99
#define PROBE_N 0
#endif
#ifndef MEGA
#define MEGA 1
#endif

typedef unsigned short bfu;
using bf16x8 = __attribute__((ext_vector_type(8))) short;
using f32x4 = __attribute__((ext_vector_type(4))) float;
using u32x4 = __attribute__((ext_vector_type(4))) unsigned;
using u32x2 = __attribute__((ext_vector_type(2))) unsigned;

constexpr int T = 32768;
constexpr int LDS_HALF = 73728;
constexpr int LDS_BYTES = 2 * LDS_HALF;
constexpr float LOG2E = 1.4426950408889634f;

constexpr size_t SZ_WGU = 5632ull * 1024 * 2;
constexpr size_t SZ_WD = 1024ull * 2816 * 2;
constexpr size_t OFF_WGU1 = 0;
constexpr size_t OFF_WD1 = OFF_WGU1 + SZ_WGU;
constexpr size_t OFF_WGU2 = OFF_WD1 + SZ_WD;
constexpr size_t OFF_WD2 = OFF_WGU2 + SZ_WGU;
constexpr size_t OFF_WINA = OFF_WD2 + SZ_WD;
constexpr size_t OFF_WING = OFF_WINA + 2304ull * 1024 * 2;
constexpr size_t OFF_WBR = OFF_WING + 5120ull * 1024 * 2;
constexpr size_t OFF_WOUT = OFF_WBR + 5ull * 1024 * 256 * 2;
constexpr size_t OFF_WMEM = OFF_WOUT + 1024ull * 1024 * 2;
constexpr size_t OFF_WGLU = OFF_WMEM + 512ull * 1024 * 2;
constexpr size_t OFF_WQUP = OFF_WGLU + 256ull * 256 * 2;
constexpr size_t OFF_WKVUP = OFF_WQUP + 384ull * 192 * 2;
constexpr size_t OFF_XN = OFF_WKVUP + 512ull * 128 * 2;
constexpr size_t OFF_RA = OFF_XN + (size_t)T * 1024 * 2;
constexpr size_t OFF_RC = OFF_RA + (size_t)T * 2176 * 2;
constexpr size_t OFF_MEMN = OFF_RC + (size_t)T * 1024 * 2;
constexpr size_t OFF_MEMKV = OFF_MEMN + 1536ull * 1024 * 2;
constexpr size_t OFF_S5E = OFF_MEMKV + 1536ull * 512 * 2;
constexpr size_t OFF_SA = OFF_S5E + 1024ull * 2048 * 8;
constexpr size_t OFF_SAP = OFF_SA + 2048 * 8;
constexpr size_t OFF_SBB = OFF_SAP + 2048 * 8;
constexpr size_t OFF_ROPE = OFF_SBB + 2048ull * 16 * 8;
constexpr size_t OFF_T5 = OFF_ROPE + 8192ull * 16 * 4 * 2;
constexpr size_t OFF_BBH = OFF_T5 + 8192;
constexpr size_t OFF_CCH = OFF_BBH + 131072;
constexpr size_t OFF_BAR = OFF_CCH + 131072;
constexpr size_t WS_END = OFF_BAR + 256;

struct Params {
  const float* in[35];
  float* out;
  unsigned char* ws;
};

__device__ __forceinline__ int get_tid() { int t = threadIdx.x & 255; asm volatile("" : "+v"(t)); return t; }
__device__ __forceinline__ int get_tid512() { int t = threadIdx.x; asm volatile("" : "+v"(t)); return t; }
__device__ __forceinline__ int vb_id() { return __builtin_amdgcn_readfirstlane((int)(threadIdx.x >> 8)); }
#define VBLK ((int)blockIdx.x * 2 + vb_id())
#define VGRID ((int)gridDim.x * 2)
typedef __bf16 hbf16x2 __attribute__((ext_vector_type(2)));
typedef float hf32x2 __attribute__((ext_vector_type(2)));
__device__ __forceinline__ unsigned pack2(float a, float b) {
  const hf32x2 v = {a, b};
  const hbf16x2 h = __builtin_convertvector(v, hbf16x2);
  return __builtin_bit_cast(unsigned, h);
}
__device__ __forceinline__ unsigned short f2bf(float f) { return (unsigned short)(pack2(f, 0.f) & 0xFFFFu); }
__device__ __forceinline__ float bf2f(unsigned short b) { return __uint_as_float(((unsigned)b) << 16); }
__device__ __forceinline__ float bflo(unsigned u) { return __uint_as_float(u << 16); }
__device__ __forceinline__ float bfhi(unsigned u) { return __uint_as_float(u & 0xFFFF0000u); }
__device__ __forceinline__ float wave_sum(float v) {
#pragma unroll
  for (int o = 32; o > 0; o >>= 1) v += __shfl_xor(v, o);
  return v;
}
__device__ __forceinline__ float sigmoidf_(float x) { return __builtin_amdgcn_rcpf(1.f + __expf(-x)); }
__device__ __forceinline__ float geluf_(float x) {
  float z = 0.7978845608028654f * (x + 0.044715f * x * x * x);
  float th = 1.f - 2.f * __builtin_amdgcn_rcpf(1.f + __expf(2.f * z));
  return 0.5f * x * (1.f + th);
}
__device__ __forceinline__ void seq_of_token(int t, int& start, int& len) {
  if (t < 16384) { start = t & ~8191; len = 8192; }
  else { start = 16384 + ((t - 16384) & ~4095); len = 4096; }
}
__device__ __forceinline__ void unpack8(const u32x4& u, float* f) {
  f[0] = bflo(u.x); f[1] = bfhi(u.x); f[2] = bflo(u.y); f[3] = bfhi(u.y);
  f[4] = bflo(u.z); f[5] = bfhi(u.z); f[6] = bflo(u.w); f[7] = bfhi(u.w);
}

template <int WN>
__device__ __forceinline__ void gemm_main(f32x4 (&acc)[4][WN], const bfu* A, int lda, const bfu* B, int ldb, int K,
                                          unsigned char* smem) {
  constexpr int BN = 32 * WN;
  constexpr int NB = BN / 32;
  constexpr int RS = (WN == 2) ? 160 : 144;
  constexpr int ASZ = 128 * RS, BSZ = BN * RS;
  const int tid = get_tid(), lane = tid & 63, wave = tid >> 6, fr = lane & 15, fq = lane >> 4, wm = wave >> 1, wn = wave & 1;
  unsigned char* As = smem;
  unsigned char* Bs = smem + 2 * ASZ;
  const int lr = tid >> 3, lc = tid & 7;
  u32x4 ra[4], rb[NB];
  const bfu* Ap = A + (size_t)lr * lda + lc * 8;
  const bfu* Bp = B + (size_t)lr * ldb + lc * 8;
  const int nk = K >> 6;
#pragma unroll
  for (int i = 0; i < 4; ++i) ra[i] = *(const u32x4*)(Ap + (size_t)i * 32 * lda);
#pragma unroll
  for (int i = 0; i < NB; ++i) rb[i] = *(const u32x4*)(Bp + (size_t)i * 32 * ldb);
  __syncthreads();
#pragma unroll
  for (int i = 0; i < 4; ++i) *(u32x4*)(As + (lr + 32 * i) * RS + lc * 16) = ra[i];
#pragma unroll
  for (int i = 0; i < NB; ++i) *(u32x4*)(Bs + (lr + 32 * i) * RS + lc * 16) = rb[i];
  __syncthreads();
  for (int kt = 0; kt < nk; ++kt) {
    const int cur = kt & 1;
    {
      const int kn = min(kt + 1, nk - 1);
      const bfu* Ap2 = Ap + kn * 64;
      const bfu* Bp2 = Bp + kn * 64;
#pragma unroll
      for (int i = 0; i < 4; ++i) ra[i] = *(const u32x4*)(Ap2 + (size_t)i * 32 * lda);
#pragma unroll
      for (int i = 0; i < NB; ++i) rb[i] = *(const u32x4*)(Bp2 + (size_t)i * 32 * ldb);
    }
    __builtin_amdgcn_sched_barrier(0);
    const unsigned char* Ac = As + cur * ASZ;
    const unsigned char* Bc = Bs + cur * BSZ;
#pragma unroll
    for (int kk = 0; kk < 2; ++kk) {
      bf16x8 af[4], bfv[WN];
#pragma unroll
      for (int mi = 0; mi < 4; ++mi) af[mi] = *(const bf16x8*)(Ac + (wm * 64 + mi * 16 + fr) * RS + kk * 64 + fq * 16);
#pragma unroll
      for (int ni = 0; ni < WN; ++ni) bfv[ni] = *(const bf16x8*)(Bc + (wn * 16 * WN + ni * 16 + fr) * RS + kk * 64 + fq * 16);
#pragma unroll
      for (int mi = 0; mi < 4; ++mi)
#pragma unroll
        for (int ni = 0; ni < WN; ++ni) acc[mi][ni] = __builtin_amdgcn_mfma_f32_16x16x32_bf16(af[mi], bfv[ni], acc[mi][ni], 0, 0, 0);
    }
    {
      unsigned char* An = As + (cur ^ 1) * ASZ;
      unsigned char* Bn = Bs + (cur ^ 1) * BSZ;
#pragma unroll
      for (int i = 0; i < 4; ++i) *(u32x4*)(An + (lr + 32 * i) * RS + lc * 16) = ra[i];
#pragma unroll
      for (int i = 0; i < NB; ++i) *(u32x4*)(Bn + (lr + 32 * i) * RS + lc * 16) = rb[i];
    }
    __syncthreads();
  }
}

template <int WN>
__device__ __forceinline__ void gemm_chain(f32x4 (&acc)[4][WN], const bfu* A, int lda, const bfu* B, int ldb, int K,
                                           unsigned char* smem, bool first, bool has_next, const bfu* nA, int nlda, const bfu* nB, int nldb) {
  constexpr int BN = 32 * WN;
  constexpr int NB = BN / 32;
  constexpr int RS = (WN == 2) ? 160 : 144;
  constexpr int ASZ = 128 * RS, BSZ = BN * RS;
  const int tid = get_tid(), lane = tid & 63, wave = tid >> 6, fr = lane & 15, fq = lane >> 4, wm = wave >> 1, wn = wave & 1;
  unsigned char* As = smem;
  unsigned char* Bs = smem + 2 * ASZ;
  const int lr = tid >> 3, lc = tid & 7;
  u32x4 ra[4], rb[NB];
  const bfu* Ap = A + (size_t)lr * lda + lc * 8;
  const bfu* Bp = B + (size_t)lr * ldb + lc * 8;
  const int nk = K >> 6;
  if (first) {
#pragma unroll
    for (int i = 0; i < 4; ++i) ra[i] = *(const u32x4*)(Ap + (size_t)i * 32 * lda);
#pragma unroll
    for (int i = 0; i < NB; ++i) rb[i] = *(const u32x4*)(Bp + (size_t)i * 32 * ldb);
    __syncthreads();
#pragma unroll
    for (int i = 0; i < 4; ++i) *(u32x4*)(As + (lr + 32 * i) * RS + lc * 16) = ra[i];
#pragma unroll
    for (int i = 0; i < NB; ++i) *(u32x4*)(Bs + (lr + 32 * i) * RS + lc * 16) = rb[i];
    __syncthreads();
  }
  const bfu* nAp = nA + (size_t)lr * nlda + lc * 8;
  const bfu* nBp = nB + (size_t)lr * nldb + lc * 8;
  for (int kt = 0; kt < nk; ++kt) {
    const int cur = kt & 1;
    {
      const bool nx = (kt + 1 >= nk) && has_next;
      const int kn = min(kt + 1, nk - 1);
      const bfu* Ap2 = nx ? nAp : Ap + kn * 64;
      const bfu* Bp2 = nx ? nBp : Bp + kn * 64;
      const size_t sa = (size_t)32 * (nx ? nlda : lda), sb = (size_t)32 * (nx ? nldb : ldb);
#pragma unroll
      for (int i = 0; i < 4; ++i) ra[i] = *(const u32x4*)(Ap2 + i * sa);
#pragma unroll
      for (int i = 0; i < NB; ++i) rb[i] = *(const u32x4*)(Bp2 + i * sb);
    }
    __builtin_amdgcn_sched_barrier(0);
    const unsigned char* Ac = As + cur * ASZ;
    const unsigned char* Bc = Bs + cur * BSZ;
#pragma unroll
    for (int kk = 0; kk < 2; ++kk) {
      bf16x8 af[4], bfv[WN];
#pragma unroll
      for (int mi = 0; mi < 4; ++mi) af[mi] = *(const bf16x8*)(Ac + (wm * 64 + mi * 16 + fr) * RS + kk * 64 + fq * 16);
#pragma unroll
      for (int ni = 0; ni < WN; ++ni) bfv[ni] = *(const bf16x8*)(Bc + (wn * 16 * WN + ni * 16 + fr) * RS + kk * 64 + fq * 16);
#pragma unroll
      for (int mi = 0; mi < 4; ++mi)
#pragma unroll
        for (int ni = 0; ni < WN; ++ni) acc[mi][ni] = __builtin_amdgcn_mfma_f32_16x16x32_bf16(af[mi], bfv[ni], acc[mi][ni], 0, 0, 0);
    }
    {
      unsigned char* An = As + (cur ^ 1) * ASZ;
      unsigned char* Bn = Bs + (cur ^ 1) * BSZ;
#pragma unroll
      for (int i = 0; i < 4; ++i) *(u32x4*)(An + (lr + 32 * i) * RS + lc * 16) = ra[i];
#pragma unroll
      for (int i = 0; i < NB; ++i) *(u32x4*)(Bn + (lr + 32 * i) * RS + lc * 16) = rb[i];
    }
    __syncthreads();
  }
}

__device__ __forceinline__ void gemm_chain8(f32x4 (&acc)[4][2], const bfu* A, int lda, const bfu* B, int ldb, int K,
                                           unsigned char* smem, bool first, bool has_next, const bfu* nA, int nlda, const bfu* nB, int nldb) {
  constexpr int WN = 2;
  constexpr int RS = 160;
  constexpr int ASZ = 128 * RS, BSZ = 128 * RS;
  const int tid = get_tid512(), lane = tid & 63, wave = tid >> 6, fr = lane & 15, fq = lane >> 4, wm = wave >> 2, wn = wave & 3;
  unsigned char* As = smem;
  unsigned char* Bs = smem + 2 * ASZ;
  const int lr = tid >> 3, lc = tid & 7;
  u32x4 ra[2], rb[2];
  const bfu* Ap = A + (size_t)lr * lda + lc * 8;
  const bfu* Bp = B + (size_t)lr * ldb + lc * 8;
  const int nk = K >> 6;
  if (first) {
#pragma unroll
    for (int i = 0; i < 2; ++i) ra[i] = *(const u32x4*)(Ap + (size_t)i * 64 * lda);
#pragma unroll
    for (int i = 0; i < 2; ++i) rb[i] = *(const u32x4*)(Bp + (size_t)i * 64 * ldb);
    __syncthreads();
#pragma unroll
    for (int i = 0; i < 2; ++i) *(u32x4*)(As + (lr + 64 * i) * RS + lc * 16) = ra[i];
#pragma unroll
    for (int i = 0; i < 2; ++i) *(u32x4*)(Bs + (lr + 64 * i) * RS + lc * 16) = rb[i];
    __syncthreads();
  }
  const bfu* nAp = nA + (size_t)lr * nlda + lc * 8;
  const bfu* nBp = nB + (size_t)lr * nldb + lc * 8;
  for (int kt = 0; kt < nk; ++kt) {
    const int cur = kt & 1;
    {
      const bool nx = (kt + 1 >= nk) && has_next;
      const int kn = min(kt + 1, nk - 1);
      const bfu* Ap2 = nx ? nAp : Ap + kn * 64;
      const bfu* Bp2 = nx ? nBp : Bp + kn * 64;
      const size_t sa = (size_t)64 * (nx ? nlda : lda), sb = (size_t)64 * (nx ? nldb : ldb);
#pragma unroll
      for (int i = 0; i < 2; ++i) ra[i] = *(const u32x4*)(Ap2 + i * sa);
#pragma unroll
      for (int i = 0; i < 2; ++i) rb[i] = *(const u32x4*)(Bp2 + i * sb);
    }
    __builtin_amdgcn_sched_barrier(0);
    const unsigned char* Ac = As + cur * ASZ;
    const unsigned char* Bc = Bs + cur * BSZ;
#pragma unroll
    for (int kk = 0; kk < 2; ++kk) {
      bf16x8 af[4], bfv[WN];
#pragma unroll
      for (int mi = 0; mi < 4; ++mi) af[mi] = *(const bf16x8*)(Ac + (wm * 64 + mi * 16 + fr) * RS + kk * 64 + fq * 16);
#pragma unroll
      for (int ni = 0; ni < WN; ++ni) bfv[ni] = *(const bf16x8*)(Bc + (wn * 16 * WN + ni * 16 + fr) * RS + kk * 64 + fq * 16);
#pragma unroll
      for (int mi = 0; mi < 4; ++mi)
#pragma unroll
        for (int ni = 0; ni < WN; ++ni) acc[mi][ni] = __builtin_amdgcn_mfma_f32_16x16x32_bf16(af[mi], bfv[ni], acc[mi][ni], 0, 0, 0);
    }
    {
      unsigned char* An = As + (cur ^ 1) * ASZ;
      unsigned char* Bn = Bs + (cur ^ 1) * BSZ;
#pragma unroll
      for (int i = 0; i < 2; ++i) *(u32x4*)(An + (lr + 64 * i) * RS + lc * 16) = ra[i];
#pragma unroll
      for (int i = 0; i < 2; ++i) *(u32x4*)(Bn + (lr + 64 * i) * RS + lc * 16) = rb[i];
    }
    __syncthreads();
  }
}

template <int WN>
__device__ __forceinline__ void zero_acc(f32x4 (&acc)[4][WN]) {
#pragma unroll
  for (int mi = 0; mi < 4; ++mi)
#pragma unroll
    for (int ni = 0; ni < WN; ++ni) acc[mi][ni] = f32x4{0.f, 0.f, 0.f, 0.f};
}

template <int WN>
__device__ __forceinline__ void acc_to_lds(const f32x4 (&acc)[4][WN], unsigned char* smem) {
  constexpr int LDC = 32 * WN + 4;
  const int tid = get_tid(), lane = tid & 63, wave = tid >> 6, fr = lane & 15, fq = lane >> 4, wm = wave >> 1, wn = wave & 1;
  float* Cs = (float*)smem;
#pragma unroll
  for (int mi = 0; mi < 4; ++mi)
#pragma unroll
    for (int ni = 0; ni < WN; ++ni)
#pragma unroll
      for (int j = 0; j < 4; ++j) Cs[(wm * 64 + mi * 16 + fq * 4 + j) * LDC + wn * 16 * WN + ni * 16 + fr] = acc[mi][ni][j];
  __syncthreads();
}


__device__ __forceinline__ void gemm_big(f32x4 (&acc)[8][4], const bfu* A, int lda, const bfu* B, int ldb, int K, unsigned char* smem) {
  constexpr int ASZ = 256 * 64, STG = 2 * ASZ;
  const int tid = get_tid512(), lane = tid & 63, wave = tid >> 6, fr = lane & 15, fq = lane >> 4, wm = wave >> 2, wn = wave & 3;
  const int nk = K >> 5;
  const int lrow = lane >> 2;
  const int lchunk = (lane & 3) ^ ((lane >> 4) & 2);
  const bfu* Ag = A + (size_t)(wave * 32 + lrow) * lda + lchunk * 8;
  const bfu* Bg = B + (size_t)(wave * 32 + lrow) * ldb + lchunk * 8;
  const int rd_off = fr * 64 + ((fq ^ ((fr >> 2) & 2)) << 4);
  asm volatile("s_waitcnt vmcnt(0)" ::: "memory");
  __syncthreads();
#define GB_ISSUE(kt_, stg_)                                                                                           \
  {                                                                                                                   \
    unsigned char* sb_ = smem + (stg_) * STG;                                                                         \
    _Pragma("unroll") for (int jj = 0; jj < 2; ++jj)                                                                  \
      __builtin_amdgcn_global_load_lds((const unsigned*)(Ag + (size_t)jj * 16 * lda + (kt_) * 32),                    \
                                       (__attribute__((address_space(3))) unsigned*)(sb_ + (wave * 32 + jj * 16) * 64), 16, 0, 0); \
    _Pragma("unroll") for (int jj = 0; jj < 2; ++jj)                                                                  \
      __builtin_amdgcn_global_load_lds((const unsigned*)(Bg + (size_t)jj * 16 * ldb + (kt_) * 32),                    \
                                       (__attribute__((address_space(3))) unsigned*)(sb_ + ASZ + (wave * 32 + jj * 16) * 64), 16, 0, 0); \
  }
  const int grp = __builtin_amdgcn_readfirstlane(wm);
  GB_ISSUE(0, 0);
  if (nk > 1) { GB_ISSUE(1, 1); asm volatile("s_waitcnt vmcnt(4)" ::: "memory"); }
  else asm volatile("s_waitcnt vmcnt(0)" ::: "memory");
  if (grp == 1) __builtin_amdgcn_s_barrier();
  __builtin_amdgcn_s_barrier();
  int stg = 0;
  for (int kt = 0; kt < nk; ++kt) {
    if (kt + 2 < nk) {
      const int s2 = (stg >= 1) ? stg - 1 : 2;
      GB_ISSUE(kt + 2, s2);
    }
    const unsigned char* Ac = smem + stg * STG + rd_off;
    const unsigned char* Bc = Ac + ASZ;
    bf16x8 bfv[4], af[8];
#pragma unroll
    for (int ni = 0; ni < 4; ++ni) bfv[ni] = *(const bf16x8*)(Bc + (wn * 64 + ni * 16) * 64);
#pragma unroll
    for (int mi = 0; mi < 8; ++mi) af[mi] = *(const bf16x8*)(Ac + (wm * 128 + mi * 16) * 64);
    if (kt + 2 < nk) asm volatile("s_waitcnt vmcnt(4)" ::: "memory");
    else asm volatile("s_waitcnt vmcnt(0)" ::: "memory");
    asm volatile("s_waitcnt lgkmcnt(0)" ::: "memory");
    __builtin_amdgcn_sched_barrier(0);
    __builtin_amdgcn_s_barrier();
    __builtin_amdgcn_sched_barrier(0);
    __builtin_amdgcn_s_setprio(1);
#pragma unroll
    for (int mi = 0; mi < 8; ++mi)
#pragma unroll
      for (int ni = 0; ni < 4; ++ni)
        acc[mi][ni] = __builtin_amdgcn_mfma_f32_16x16x32_bf16(af[mi], bfv[ni], acc[mi][ni], 0, 0, 0);
    __builtin_amdgcn_s_setprio(0);
    __builtin_amdgcn_sched_barrier(0);
    __builtin_amdgcn_s_barrier();
    __builtin_amdgcn_sched_barrier(0);
    stg = (stg == 2) ? 0 : stg + 1;
  }
  if (grp == 0) __builtin_amdgcn_s_barrier();
#undef GB_ISSUE
}
__device__ __forceinline__ void zero_acc_big(f32x4 (&acc)[8][4]) {
#pragma unroll
  for (int mi = 0; mi < 8; ++mi)
#pragma unroll
    for (int ni = 0; ni < 4; ++ni) acc[mi][ni] = f32x4{0.f, 0.f, 0.f, 0.f};
}
__device__ __forceinline__ void acc_to_lds_big(const f32x4 (&acc)[8][4], int ch, unsigned char* smem) {
  const int tid = get_tid512(), lane = tid & 63, wave = tid >> 6, fr = lane & 15, fq = lane >> 4, wm = wave >> 2, wn = wave & 3;
  float* Cs = (float*)smem;
  __syncthreads();
  if ((wn >> 1) == ch) {
#pragma unroll
    for (int mi = 0; mi < 8; ++mi)
#pragma unroll
      for (int ni = 0; ni < 4; ++ni)
#pragma unroll
        for (int j = 0; j < 4; ++j) Cs[(wm * 128 + mi * 16 + fq * 4 + j) * 132 + (wn & 1) * 64 + ni * 16 + fr] = acc[mi][ni][j];
  }
  __syncthreads();
}

__device__ __forceinline__ void tile_mn(int id, int Mt, int Nt, int& mt, int& nt) {
  const int per = 8 * Nt;
  const int grp = id / per, within = id - grp * per;
  const int gsz = min(8, Mt - grp * 8);
  mt = grp * 8 + within % gsz;
  nt = within / gsz;
}
#define FOR_TILES(id, n)                                                              \
  for (int _q = blockIdx.x >> 3; ((_q >> 6) << 9) < (n); _q += (gridDim.x >> 3))       \
    for (int id = ((_q >> 6) << 9) + ((blockIdx.x & 7) << 6) + (_q & 63), _once = 1; _once && id < (n); _once = 0)
#define FOR_TILES_V(id, n)                                                                            \
  for (int _q = ((blockIdx.x >> 3) << 1) + vb_id(); ((_q >> 6) << 9) < (n); _q += ((gridDim.x >> 3) << 1)) \
    for (int id = ((_q >> 6) << 9) + ((blockIdx.x & 7) << 6) + (_q & 63), _once = 1; _once && id < (n); _once = 0)

struct CD { const float* src; bfu* dst; const float* ks; int sld, c0, K, Nv, Np, mode; };

__device__ __forceinline__ void get_cd(const Params& p, int l, int idx, CD& d) {
  unsigned char* ws = p.ws;
  d.ks = nullptr; d.c0 = 0; d.mode = 0;
  switch (idx) {
    case 0: case 1:
      d.src = p.in[idx == 0 ? 5 : 6] + (size_t)l * 1024 * 2816; d.sld = 2816; d.K = 1024; d.Nv = 2816; d.Np = 2816; d.mode = idx + 1; d.dst = (bfu*)(ws + OFF_WGU1); break;
    case 2:
      d.src = p.in[7] + (size_t)l * 2816 * 1024; d.sld = 1024; d.K = 2816; d.Nv = 1024; d.Np = 1024; d.dst = (bfu*)(ws + OFF_WD1); break;
    case 3: case 4:
      d.src = p.in[idx == 3 ? 31 : 32] + (size_t)l * 1024 * 2816; d.sld = 2816; d.K = 1024; d.Nv = 2816; d.Np = 2816; d.mode = idx - 2; d.dst = (bfu*)(ws + OFF_WGU2); break;
    case 5:
      d.src = p.in[33] + (size_t)l * 2816 * 1024; d.sld = 1024; d.K = 2816; d.Nv = 1024; d.Np = 1024; d.dst = (bfu*)(ws + OFF_WD2); break;
    case 6:
      d.src = p.in[9] + (size_t)l * 1024 * 7264; d.sld = 7264; d.K = 1024; d.Nv = 2144; d.Np = 2304; d.dst = (bfu*)(ws + OFF_WINA); break;
    case 7:
      d.src = p.in[9] + (size_t)l * 1024 * 7264; d.sld = 7264; d.c0 = 2144; d.K = 1024; d.Nv = 5120; d.Np = 5120; d.dst = (bfu*)(ws + OFF_WING); break;
    case 8: case 9: case 10: case 11: case 12:
      d.src = p.in[28] + (size_t)(l * 5 + (idx - 8)) * 256 * 1024; d.sld = 1024; d.K = 256; d.Nv = 1024; d.Np = 1024; d.dst = (bfu*)(ws + OFF_WBR) + (size_t)(idx - 8) * 1024 * 256; break;
    case 13:
      d.src = p.in[29] + (size_t)l * 1024 * 1024; d.sld = 1024; d.K = 1024; d.Nv = 1024; d.Np = 1024; d.dst = (bfu*)(ws + OFF_WOUT); break;
    case 14:
      d.src = p.in[27] + (size_t)l * 1024 * 512; d.sld = 512; d.K = 1024; d.Nv = 512; d.Np = 512; d.dst = (bfu*)(ws + OFF_WMEM); break;
    case 15:
      d.src = p.in[18] + (size_t)l * 65536; d.sld = 256; d.K = 256; d.Nv = 256; d.Np = 256; d.dst = (bfu*)(ws + OFF_WGLU); break;
    case 16:
      d.src = p.in[23] + (size_t)l * 192 * 384; d.sld = 384; d.K = 192; d.Nv = 384; d.Np = 384; d.ks = p.in[22] + l * 192; d.dst = (bfu*)(ws + OFF_WQUP); break;
    default:
      d.src = p.in[25] + (size_t)l * 128 * 512; d.sld = 512; d.K = 128; d.Nv = 512; d.Np = 512; d.ks = p.in[24] + l * 128; d.dst = (bfu*)(ws + OFF_WKVUP); break;
  }
}
constexpr int NCD = 18;
__device__ __forceinline__ int cd_tiles(int idx) {
  switch (idx) {
    case 0: case 1: case 3: case 4: return 16 * 44;
    case 2: case 5: return 44 * 16;
    case 6: return 16 * 36;
    case 7: return 16 * 80;
    case 8: case 9: case 10: case 11: case 12: return 4 * 16;
    case 13: return 16 * 16;
    case 14: return 16 * 8;
    case 15: return 4 * 4;
    case 16: return 3 * 6;
    default: return 2 * 8;
  }
}

__device__ __forceinline__ void conv_tile(const CD& d, int tile, unsigned char* smem) {
  float* sm = (float*)smem;
  const int tid = get_tid();
  const int tn = d.Np >> 6;
  const int tk = tile / tn, tnn = tile - tk * tn;
  const int k0 = tk * 64, n0 = tnn * 64;
  __syncthreads();
  {
    const int n = n0 + (tid & 63);
    const bool ok = n < d.Nv;
    float v[16];
#pragma unroll
    for (int i = 0; i < 16; ++i) {
      const int kr = (tid >> 6) + i * 4;
      v[i] = ok ? d.src[(size_t)(k0 + kr) * d.sld + d.c0 + n] : 0.f;
    }
    if (d.ks) {
#pragma unroll
      for (int i = 0; i < 16; ++i) v[i] *= d.ks[k0 + (tid >> 6) + i * 4];
    }
#pragma unroll
    for (int i = 0; i < 16; ++i) sm[((tid >> 6) + i * 4) * 65 + (tid & 63)] = v[i];
  }
  __syncthreads();
#pragma unroll
  for (int i = 0; i < 8; ++i) {
    const int n = (tid >> 5) + i * 8;
    const int kk = (tid & 31) * 2;
    const float v0 = sm[kk * 65 + n], v1 = sm[(kk + 1) * 65 + n];
    int drow = n0 + n;
    if (d.mode != 0) {
      const int g = drow >> 7, hc = drow & 127;
      drow = g * 256 + (hc >> 5) * 64 + ((hc >> 4) & 1) * 32 + (d.mode == 2 ? 16 : 0) + (hc & 15);
    }
    *(unsigned*)(d.dst + (size_t)drow * d.K + k0 + kk) = pack2(v0, v1);
  }
}

__device__ __forceinline__ void rms_row(const float* x, const float* g, bfu* outb, float* copy_f, float* norm_f) {
  const int lane = get_tid() & 63;
  float4 v[4];
  float ss = 0.f;
#pragma unroll
  for (int i = 0; i < 4; ++i) {
    v[i] = *(const float4*)(x + (i * 64 + lane) * 4);
    ss += v[i].x * v[i].x + v[i].y * v[i].y + v[i].z * v[i].z + v[i].w * v[i].w;
  }
  ss = wave_sum(ss);
  const float r = rsqrtf(ss * (1.f / 1024.f) + 1e-6f);
#pragma unroll
  for (int i = 0; i < 4; ++i) {
    const int idx = (i * 64 + lane) * 4;
    const float4 gg = *(const float4*)(g + idx);
    float4 y;
    y.x = v[i].x * r * gg.x; y.y = v[i].y * r * gg.y; y.z = v[i].z * r * gg.z; y.w = v[i].w * r * gg.w;
    if (outb) { u32x2 o; o.x = pack2(y.x, y.y); o.y = pack2(y.z, y.w); *(u32x2*)(outb + idx) = o; }
    if (copy_f) *(float4*)(copy_f + idx) = v[i];
    if (norm_f) *(float4*)(norm_f + idx) = y;
  }
}

__device__ __forceinline__ void norm_rows_phase(const Params& p, const float* gain, int first_layer_copy, int w) {
  const int row = w * 4 + (get_tid() >> 6);
  bfu* xn = (bfu*)(p.ws + OFF_XN) + (size_t)row * 1024;
  if (first_layer_copy) {
    const float* x = (row < 16384) ? (p.in[0] + (size_t)row * 1024) : (p.in[1] + (size_t)(row - 16384) * 1024);
    rms_row(x, gain, xn, p.out + (size_t)row * 1024, nullptr);
  } else {
    rms_row(p.out + (size_t)row * 1024, gain, xn, nullptr, nullptr);
  }
}

__device__ __forceinline__ int t5_bucket(int rel) {
  const int nb = 16, max_exact = 8;
  int ret = (rel > 0) ? nb : 0;
  int n = rel < 0 ? -rel : rel;
  if (n < max_exact) return ret + n;
  int large = max_exact + (int)(log((double)n / 8.0) / log(16.0) * 8.0 + 1e-9);
  if (large > nb - 1) large = nb - 1;
  return ret + large;
}

__device__ __forceinline__ void phase_prep(const Params& p, int l, unsigned char* smem) {
  int nconv = 0;
#pragma unroll 1
  for (int i = 0; i < NCD; ++i) nconv += cd_tiles(i);
  for (int w = VBLK; w < nconv; w += VGRID) {
    int x = w;
    int i = 0;
    while (x >= cd_tiles(i)) { x -= cd_tiles(i); ++i; }
    CD d; get_cd(p, l, i, d);
    conv_tile(d, x, smem);
  }
  const int n_norm = T / 4, n_mem = 1536 / 4;
  for (int w = VBLK; w < n_norm + n_mem; w += VGRID) {
    if (w < n_norm) { norm_rows_phase(p, p.in[4] + l * 1024, l == 0, w); }
    else {
      const int row = (w - n_norm) * 4 + (get_tid() >> 6);
      const float* src = (row < 512) ? (p.in[2] + (size_t)row * 1024) : (p.in[3] + (size_t)(row - 512) * 1024);
      rms_row(src, p.in[26] + l * 1024, (bfu*)(p.ws + OFF_MEMN) + (size_t)row * 1024, nullptr, nullptr);
    }
  }
  const int n_ssm = 8;
  const int n_misc = (l == 0) ? (512 + 5) : 0;
  for (int w = VGRID - 1 - VBLK; w < n_ssm + n_misc; w += VGRID) {
    int x = w;
    if (x < n_ssm) {
      const int e = x * 256 + get_tid();
      const int d = e >> 10, g = (e >> 6) & 15;
      const int li_ = (l * 2 + d) * 16 + g;
      const double lr = p.in[10][(size_t)li_ * 64 + (e & 63)], li = p.in[11][(size_t)li_ * 64 + (e & 63)];
      const double dt = exp((double)p.in[12][li_]);
      const double mag = exp(lr * dt);
      const double are = mag * cos(li * dt), aim = mag * sin(li * dt);
      const double den = lr * lr + li * li;
      const double xr = are - 1.0;
      const double kre = (xr * lr + aim * li) / den, kim = (aim * lr - xr * li) / den;
      float2* SA = (float2*)(p.ws + OFF_SA);
      float2* SAP = (float2*)(p.ws + OFF_SAP);
      float2* SBB = (float2*)(p.ws + OFF_SBB);
      SA[e] = make_float2((float)are, (float)aim);
      const double magp = exp(lr * dt * 32.0);
      SAP[e] = make_float2((float)(magp * cos(li * dt * 32.0)), (float)(magp * sin(li * dt * 32.0)));
      const float* bre = p.in[13] + ((size_t)li_ * 64 + (e & 63)) * 16;
      const float* bim = p.in[14] + ((size_t)li_ * 64 + (e & 63)) * 16;
      bfu* BBH = (bfu*)(p.ws + OFF_BBH);
      bfu* CCH = (bfu*)(p.ws + OFF_CCH);
      const int nn = e & 63;
#pragma unroll 1
      for (int pp = 0; pp < 16; ++pp) {
        const double br = bre[pp], bi = bim[pp];
        const float vre = (float)(kre * br - kim * bi), vim = (float)(kre * bi + kim * br);
        SBB[(size_t)e * 16 + pp] = make_float2(vre, vim);
        BBH[((size_t)((d * 16 + g) * 128 + nn)) * 16 + pp] = f2bf(vre);
        BBH[((size_t)((d * 16 + g) * 128 + 64 + nn)) * 16 + pp] = f2bf(vim);
        const size_t cidx = ((size_t)(li_ * 16 + pp)) * 64 + nn;
        CCH[((size_t)((d * 16 + g) * 16 + pp)) * 128 + nn] = f2bf(p.in[15][cidx]);
        CCH[((size_t)((d * 16 + g) * 16 + pp)) * 128 + 64 + nn] = f2bf(-p.in[16][cidx]);
      }
      continue;
    }
    x -= n_ssm;
    if (x < 512) {
      const int e = x * 256 + get_tid();
      const int pos = e >> 4, i = e & 15;
      const double inv = pow(10000.0, -(double)i / 16.0);
      const double ang = (double)pos * inv;
      float* rc = (float*)(p.ws + OFF_ROPE);
      rc[e] = (float)cos(ang);
      rc[8192 * 16 + e] = (float)sin(ang);
      continue;
    }
    x -= 512;
    {
      const int e = x * 256 + get_tid();
      if (e < 4 * 257) {
        const int h = e / 257, r = e - h * 257;
        float* t5 = (float*)(p.ws + OFF_T5);
        t5[e] = p.in[20][t5_bucket(r - 128) * 4 + h] * LOG2E;
      }
    }
  }
}

__device__ __forceinline__ void phase_ffn_gu(const Params& p, int which, unsigned char* smem) {
  const bfu* XN = (const bfu*)(p.ws + OFF_XN);
  const bfu* W = (const bfu*)(p.ws + (which ? OFF_WGU2 : OFF_WGU1));
  bfu* HID = (bfu*)(p.ws + OFF_RA);
  const int Mt = T / 256, Nt = 22;
  FOR_TILES(id, Mt * Nt) {
    int mt, nt; tile_mn(id, Mt, Nt, mt, nt);
    f32x4 acc[8][4]; zero_acc_big(acc);
    gemm_big(acc, XN + (size_t)mt * 256 * 1024, 1024, W + (size_t)nt * 256 * 1024, 1024, 1024, smem);
    const int tid = get_tid512(), lane = tid & 63, wave = tid >> 6, fr = lane & 15, fq = lane >> 4, wm = wave >> 2, wn = wave & 3;
    bfu* Hs = (bfu*)smem;
    __syncthreads();
#pragma unroll
    for (int mi = 0; mi < 8; ++mi)
#pragma unroll
      for (int q = 0; q < 2; ++q)
#pragma unroll
        for (int j = 0; j < 4; ++j) {
          const float g = acc[mi][2 * q][j], u = acc[mi][2 * q + 1][j];
          Hs[(wm * 128 + mi * 16 + fq * 4 + j) * 136 + wn * 32 + q * 16 + fr] = f2bf(g * sigmoidf_(g) * u);
        }
    __syncthreads();
#pragma unroll
    for (int it = 0; it < 8; ++it) {
      const int cid = it * 512 + tid;
      const int r = cid >> 4, c = (cid & 15) * 8;
      *(u32x4*)(HID + (size_t)(mt * 256 + r) * 2816 + nt * 128 + c) = *(const u32x4*)(Hs + r * 136 + c);
    }
  }
}

__device__ __forceinline__ void phase_resid_gemm(const Params& p, const bfu* A, int lda, int K, const bfu* W, float alpha, unsigned char* smem) {
  const int Mt = T / 256, Nt = 4;
  FOR_TILES(id, Mt * Nt) {
    int mt, nt; tile_mn(id, Mt, Nt, mt, nt);
    f32x4 acc[8][4]; zero_acc_big(acc);
    gemm_big(acc, A + (size_t)mt * 256 * lda, lda, W + (size_t)nt * 256 * K, K, K, smem);
    const float* Cs = (const float*)smem;
#pragma unroll 1
    for (int ch = 0; ch < 2; ++ch) {
      acc_to_lds_big(acc, ch, smem);
#pragma unroll
      for (int it = 0; it < 8; ++it) {
        const int cid = it * 512 + get_tid512();
        const int r = cid >> 4, c = (cid & 15) * 8;
        float* hp = p.out + (size_t)(mt * 256 + r) * 1024 + nt * 256 + ch * 128 + c;
        float4 h0 = *(float4*)hp, h1 = *(float4*)(hp + 4);
        const float* cs = Cs + r * 132 + c;
        h0.x += alpha * cs[0]; h0.y += alpha * cs[1]; h0.z += alpha * cs[2]; h0.w += alpha * cs[3];
        h1.x += alpha * cs[4]; h1.y += alpha * cs[5]; h1.z += alpha * cs[6]; h1.w += alpha * cs[7];
        *(float4*)hp = h0; *(float4*)(hp + 4) = h1;
      }
    }
  }
}

__device__ __forceinline__ void plain_tile(const bfu* A, int lda, const bfu* W, int K, bfu* out, int ldo, unsigned char* smem) {
  f32x4 acc[4][4]; zero_acc<4>(acc);
  gemm_main<4>(acc, A, lda, W, K, K, smem);
  acc_to_lds<4>(acc, smem);
  const float* Cs = (const float*)smem;
#pragma unroll
  for (int it = 0; it < 8; ++it) {
    const int cid = it * 256 + get_tid();
    const int r = cid >> 4, c = (cid & 15) * 8;
    const float* cs = Cs + r * 132 + c;
    u32x4 st; st.x = pack2(cs[0], cs[1]); st.y = pack2(cs[2], cs[3]); st.z = pack2(cs[4], cs[5]); st.w = pack2(cs[6], cs[7]);
    *(u32x4*)(out + (size_t)r * ldo + c) = st;
  }
}

__device__ __forceinline__ void plain_big(const bfu* A, int lda, const bfu* W, int K, bfu* out, int ldo, int ncols, unsigned char* smem) {
  f32x4 acc[8][4]; zero_acc_big(acc);
  gemm_big(acc, A, lda, W, K, K, smem);
  const int tid = get_tid512(), lane = tid & 63, wave = tid >> 6, fr = lane & 15, fq = lane >> 4, wm = wave >> 2, wn = wave & 3;
  bfu* Hs = (bfu*)smem;
  __syncthreads();
#pragma unroll
  for (int mi = 0; mi < 8; ++mi)
#pragma unroll
    for (int ni = 0; ni < 4; ++ni) {
      const unsigned p01 = pack2(acc[mi][ni][0], acc[mi][ni][1]), p23 = pack2(acc[mi][ni][2], acc[mi][ni][3]);
      bfu* hp = Hs + (wm * 128 + mi * 16 + fq * 4) * 264 + wn * 64 + ni * 16 + fr;
      hp[0] = (bfu)(p01 & 0xFFFFu); hp[264] = (bfu)(p01 >> 16); hp[528] = (bfu)(p23 & 0xFFFFu); hp[792] = (bfu)(p23 >> 16);
    }
  __syncthreads();
#pragma unroll
  for (int it = 0; it < 16; ++it) {
    const int cid = it * 512 + tid;
    const int r = cid >> 5, c = (cid & 31) * 8;
    if (c < ncols) *(u32x4*)(out + (size_t)r * ldo + c) = *(const u32x4*)(Hs + r * 264 + c);
  }
}

__device__ __forceinline__ void phase_inproj(const Params& p, unsigned char* smem) {
  const bfu* XN = (const bfu*)(p.ws + OFF_XN);
  bfu* RA = (bfu*)(p.ws + OFF_RA);
  const int Mt = T / 256, Nt = 9;
  const int n1 = Mt * Nt, n2 = 6 * 2;
  FOR_TILES(id, n1 + n2) {
    if (id < n1) {
      int mt, nt; tile_mn(id, Mt, Nt, mt, nt);
      plain_big(XN + (size_t)mt * 256 * 1024, 1024, (const bfu*)(p.ws + OFF_WINA) + (size_t)nt * 256 * 1024, 1024,
                RA + (size_t)mt * 256 * 2176 + nt * 256, 2176, 2176 - nt * 256, smem);
    } else {
      const int x = id - n1; const int mt = x >> 1, nt = x & 1;
      plain_big((const bfu*)(p.ws + OFF_MEMN) + (size_t)mt * 256 * 1024, 1024, (const bfu*)(p.ws + OFF_WMEM) + (size_t)nt * 256 * 1024, 1024,
                (bfu*)(p.ws + OFF_MEMKV) + (size_t)mt * 256 * 512 + nt * 256, 512, 256, smem);
    }
  }
}

template <bool FULL>
__device__ __forceinline__ void s5_item(const Params& p, int l, int ci, unsigned char* smem) {
  const int tid = get_tid(), lane = tid & 63, wave = tid >> 6, fr = lane & 15, fq = lane >> 4;
  bfu* ub = (bfu*)smem;
  float* BU = (float*)(smem + 16384) + wave * (16 * 128);
  bfu* SB = (bfu*)(smem + 16384 + 32768) + wave * (16 * 136);
  bfu* RA = (bfu*)(p.ws + OFF_RA);
  const bfu* src = RA + (size_t)ci * 32 * 2176;
  __syncthreads();
#pragma unroll
  for (int i = 0; i < 4; ++i) {
    const int id = tid + 256 * i; const int r = id >> 5, c = id & 31;
    *(u32x4*)(ub + r * 256 + c * 8) = *(const u32x4*)(src + (size_t)r * 2176 + c * 8);
  }
  __syncthreads();
  const float2* SA = (const float2*)(p.ws + OFF_SA);
  float2* E = (float2*)(p.ws + OFF_S5E);
  const bfu* BBH = (const bfu*)(p.ws + OFF_BBH);
  const bfu* CCH = (const bfu*)(p.ws + OFF_CCH);
  const bf16x8 zero8 = {0, 0, 0, 0, 0, 0, 0, 0};
  const float* dsk = p.in[17] + l * 256;
#pragma unroll 1
  for (int gi = 0; gi < 4; ++gi) {
    const int g = wave * 4 + gi;
    f32x4 yacc[2];
    yacc[0] = f32x4{0.f, 0.f, 0.f, 0.f}; yacc[1] = f32x4{0.f, 0.f, 0.f, 0.f};
#pragma unroll 1
    for (int d = 0; d < 2; ++d) {
      const int e = d * 1024 + g * 64 + lane;
      const float2 a = SA[e];
      float xr = 0.f, xi = 0.f;
      if (FULL) { const float2 x0 = E[(size_t)ci * 2048 + e]; xr = x0.x; xi = x0.y; }
      bf16x8 bbf[8];
#pragma unroll
      for (int nt = 0; nt < 8; ++nt)
        bbf[nt] = (fq < 2) ? *(const bf16x8*)(BBH + ((size_t)((d * 16 + g) * 128 + nt * 16 + fr)) * 16 + fq * 8) : zero8;
      bf16x8 ccf[4];
      if (FULL) {
#pragma unroll
        for (int kk = 0; kk < 4; ++kk) ccf[kk] = *(const bf16x8*)(CCH + ((size_t)((d * 16 + g) * 16 + fr)) * 128 + kk * 32 + fq * 8);
      }
#pragma unroll
      for (int s2 = 0; s2 < 2; ++s2) {
        const int sc = d ? 1 - s2 : s2;
        const bf16x8 af = (fq < 2) ? *(const bf16x8*)(ub + (sc * 16 + fr) * 256 + g * 16 + fq * 8) : zero8;
        f32x4 rr[8];
#pragma unroll
        for (int nt = 0; nt < 8; ++nt) rr[nt] = __builtin_amdgcn_mfma_f32_16x16x32_bf16(af, bbf[nt], f32x4{0.f, 0.f, 0.f, 0.f}, 0, 0, 0);
        __builtin_amdgcn_sched_barrier(0);
        asm volatile("s_nop 15\n\ts_nop 15\n\ts_nop 15" ::: "memory");
        __builtin_amdgcn_sched_barrier(0);
#pragma unroll
        for (int nt = 0; nt < 8; ++nt)
#pragma unroll
          for (int j = 0; j < 4; ++j) BU[(fq * 4 + j) * 128 + nt * 16 + fr] = rr[nt][j];
        asm volatile("s_waitcnt lgkmcnt(0)" ::: "memory");
#pragma unroll 4
        for (int st = 0; st < 16; ++st) {
          const int tt = d ? 15 - st : st;
          const float br = BU[tt * 128 + lane], bi = BU[tt * 128 + 64 + lane];
          const float nx = a.x * xr - a.y * xi + br, ny = a.x * xi + a.y * xr + bi;
          xr = nx; xi = ny;
          if (FULL) { SB[tt * 136 + lane] = f2bf(nx); SB[tt * 136 + 64 + lane] = f2bf(ny); }
        }
        asm volatile("s_waitcnt lgkmcnt(0)" ::: "memory");
        if (FULL) {
          f32x4 r = yacc[sc];
#pragma unroll
          for (int kk = 0; kk < 4; ++kk) {
            const bf16x8 sa = *(const bf16x8*)(SB + fr * 136 + kk * 32 + fq * 8);
            r = __builtin_amdgcn_mfma_f32_16x16x32_bf16(sa, ccf[kk], r, 0, 0, 0);
          }
          yacc[sc] = r;
          asm volatile("s_waitcnt lgkmcnt(0)" ::: "memory");
        }
      }
      if (!FULL) E[(size_t)ci * 2048 + e] = make_float2(xr, xi);
    }
    if (FULL) {
#pragma unroll
      for (int sc = 0; sc < 2; ++sc)
#pragma unroll
        for (int j = 0; j < 4; ++j) {
          const int t = sc * 16 + fq * 4 + j, col = g * 16 + fr;
          const float v = yacc[sc][j] + dsk[col] * bf2f(ub[t * 256 + col]);
          RA[(size_t)(ci * 32 + t) * 2176 + col] = f2bf(geluf_(v));
        }
    }
  }
}

__device__ __forceinline__ void s5a_item(const Params& p, int l, int ci, unsigned char* smem) {
  const int tid = get_tid(), lane = tid & 63, wave = tid >> 6;
  bfu* ub = (bfu*)smem;
  const bfu* src = (const bfu*)(p.ws + OFF_RA) + (size_t)ci * 32 * 2176;
  __syncthreads();
#pragma unroll
  for (int i = 0; i < 4; ++i) {
    const int id = tid + 256 * i; const int r = id >> 5, c = id & 31;
    *(u32x4*)(ub + r * 256 + c * 8) = *(const u32x4*)(src + (size_t)r * 2176 + c * 8);
  }
  __syncthreads();
  const float2* SA = (const float2*)(p.ws + OFF_SA);
  const float2* SBB = (const float2*)(p.ws + OFF_SBB);
  float2* E = (float2*)(p.ws + OFF_S5E);
  for (int gi = 0; gi < 4; ++gi) {
    const int g = wave * 4 + gi;
    for (int d = 0; d < 2; ++d) {
      const int e = d * 1024 + g * 64 + lane;
      const float2 a = SA[e];
      float bbr[16], bbi[16];
#pragma unroll
      for (int q = 0; q < 8; ++q) { const f32x4 t4 = *(const f32x4*)(SBB + (size_t)e * 16 + q * 2); bbr[2 * q] = t4[0]; bbi[2 * q] = t4[1]; bbr[2 * q + 1] = t4[2]; bbi[2 * q + 1] = t4[3]; }
      float xr = 0.f, xi = 0.f;
      for (int s = 0; s < 32; ++s) {
        const int t = d ? 31 - s : s;
        const u32x4 u0 = *(const u32x4*)(ub + t * 256 + g * 16), u1 = *(const u32x4*)(ub + t * 256 + g * 16 + 8);
        float uu[16]; unpack8(u0, uu); unpack8(u1, uu + 8);
        float br = 0.f, bi = 0.f;
#pragma unroll
        for (int q = 0; q < 16; ++q) { br += bbr[q] * uu[q]; bi += bbi[q] * uu[q]; }
        const float nx = a.x * xr - a.y * xi + br, ny = a.x * xi + a.y * xr + bi;
        xr = nx; xi = ny;
      }
      E[(size_t)ci * 2048 + e] = make_float2(xr, xi);
    }
  }
}

__device__ __forceinline__ void s5b_item(const Params& p, int w) {
  const int gid = w * 256 + get_tid();
  const int seq = gid >> 11, e = gid & 2047, d = e >> 10;
  int start, len;
  if (seq < 2) { start = seq * 8192; len = 8192; } else { start = 16384 + (seq - 2) * 4096; len = 4096; }
  const int c0 = start >> 5, nc = len >> 5;
  const float2 ap = ((const float2*)(p.ws + OFF_SAP))[e];
  float2* E = (float2*)(p.ws + OFF_S5E);
  float cr = 0.f, cim = 0.f;
  for (int b = 0; b < nc; b += 16) {
    float tr[16], ti[16];
#pragma unroll
    for (int i = 0; i < 16; ++i) { const int c = d ? (nc - 1 - (b + i)) : (b + i); const float2 tt = E[(size_t)(c0 + c) * 2048 + e]; tr[i] = tt.x; ti[i] = tt.y; }
#pragma unroll
    for (int i = 0; i < 16; ++i) {
      const int c = d ? (nc - 1 - (b + i)) : (b + i);
      E[(size_t)(c0 + c) * 2048 + e] = make_float2(cr, cim);
      const float nr = ap.x * cr - ap.y * cim + tr[i], ni = ap.x * cim + ap.y * cr + ti[i];
      cr = nr; cim = ni;
    }
  }
}

__device__ __forceinline__ void s5c_item(const Params& p, int l, int ci, unsigned char* smem) {
  const int tid = get_tid(), lane = tid & 63, wave = tid >> 6;
  bfu* ub = (bfu*)smem;
  float* y = (float*)(smem + 16384);
  float* sre = (float*)(smem + 49152) + wave * (2 * 8 * 68);
  float* sim = sre + 8 * 68;
  bfu* RA = (bfu*)(p.ws + OFF_RA);
  const bfu* src = RA + (size_t)ci * 32 * 2176;
  __syncthreads();
#pragma unroll
  for (int i = 0; i < 4; ++i) {
    const int id = tid + 256 * i; const int r = id >> 5, c = id & 31;
    *(u32x4*)(ub + r * 256 + c * 8) = *(const u32x4*)(src + (size_t)r * 2176 + c * 8);
  }
#pragma unroll
  for (int i = 0; i < 32; ++i) y[tid + 256 * i] = 0.f;
  __syncthreads();
  const float2* SA = (const float2*)(p.ws + OFF_SA);
  const float2* SBB = (const float2*)(p.ws + OFF_SBB);
  const float2* E = (const float2*)(p.ws + OFF_S5E);
  const int tsub = lane >> 4, pp = lane & 15;
  for (int gi = 0; gi < 4; ++gi) {
    const int g = wave * 4 + gi;
    for (int d = 0; d < 2; ++d) {
      const int e = d * 1024 + g * 64 + lane;
      const float2 a = SA[e];
      float bbr[16], bbi[16];
#pragma unroll
      for (int q = 0; q < 8; ++q) { const f32x4 t4 = *(const f32x4*)(SBB + (size_t)e * 16 + q * 2); bbr[2 * q] = t4[0]; bbi[2 * q] = t4[1]; bbr[2 * q + 1] = t4[2]; bbi[2 * q + 1] = t4[3]; }
      const float2 x0 = E[(size_t)ci * 2048 + e];
      float xr = x0.x, xi = x0.y;
      const float* cre = p.in[15] + ((size_t)(((l * 2 + d) * 16 + g) * 16 + pp)) * 64;
      const float* cim = p.in[16] + ((size_t)(((l * 2 + d) * 16 + g) * 16 + pp)) * 64;
      for (int sb = 0; sb < 4; ++sb) {
#pragma unroll 1
        for (int k = 0; k < 8; ++k) {
          const int s = sb * 8 + k;
          const int t = d ? 31 - s : s;
          const u32x4 u0 = *(const u32x4*)(ub + t * 256 + g * 16), u1 = *(const u32x4*)(ub + t * 256 + g * 16 + 8);
          float uu[16]; unpack8(u0, uu); unpack8(u1, uu + 8);
          float br = 0.f, bi = 0.f;
#pragma unroll
          for (int q = 0; q < 16; ++q) { br += bbr[q] * uu[q]; bi += bbi[q] * uu[q]; }
          const float nx = a.x * xr - a.y * xi + br, ny = a.x * xi + a.y * xr + bi;
          xr = nx; xi = ny;
          sre[k * 68 + lane] = nx; sim[k * 68 + lane] = ny;
        }
        __syncthreads();
        float a0 = 0.f, a1 = 0.f;
#pragma unroll 2
        for (int n4 = 0; n4 < 16; ++n4) {
          const float4 cr4 = *(const float4*)(cre + n4 * 4), ci4 = *(const float4*)(cim + n4 * 4);
          const float4 r0 = *(const float4*)(sre + tsub * 68 + n4 * 4), i0 = *(const float4*)(sim + tsub * 68 + n4 * 4);
          const float4 r1 = *(const float4*)(sre + (tsub + 4) * 68 + n4 * 4), i1 = *(const float4*)(sim + (tsub + 4) * 68 + n4 * 4);
          a0 += cr4.x * r0.x + cr4.y * r0.y + cr4.z * r0.z + cr4.w * r0.w - (ci4.x * i0.x + ci4.y * i0.y + ci4.z * i0.z + ci4.w * i0.w);
          a1 += cr4.x * r1.x + cr4.y * r1.y + cr4.z * r1.z + cr4.w * r1.w - (ci4.x * i1.x + ci4.y * i1.y + ci4.z * i1.z + ci4.w * i1.w);
        }
        const int s0 = sb * 8 + tsub, s1 = s0 + 4;
        const int t0 = d ? 31 - s0 : s0, t1 = d ? 31 - s1 : s1;
        y[t0 * 256 + g * 16 + pp] += a0;
        y[t1 * 256 + g * 16 + pp] += a1;
        __syncthreads();
      }
    }
  }
  __syncthreads();
  const float* dsk = p.in[17] + l * 256;
#pragma unroll 4
  for (int i = 0; i < 32; ++i) {
    const int id = tid + 256 * i; const int t = id >> 8, col = id & 255;
    const float v = y[id] + dsk[col] * bf2f(ub[id]);
    RA[(size_t)(ci * 32 + t) * 2176 + col] = f2bf(geluf_(v));
  }
}

__device__ __forceinline__ void mla_prep_tile(const Params& p, int x, unsigned char* smem) {
  const int tid = get_tid();
  bfu* RA = (bfu*)(p.ws + OFF_RA);
  bfu* Qb = (bfu*)(p.ws + OFF_RC);
  bfu* Kb = Qb + (size_t)T * 384;
  bfu* Vb = Qb + (size_t)T * 768;
  const float* rc = (const float*)(p.ws + OFF_ROPE);
  const float* rs_ = rc + 8192 * 16;
  float* rinv = (float*)(smem + 67584);
  const float* Cs = (const float*)smem;
  int mt, j;
  if (x < 768) { mt = x / 3; j = x - mt * 3; } else { const int y = x - 768; mt = y >> 2; j = 3 + (y & 3); }
  const int m0 = mt * 128;
  int sstart, slen; seq_of_token(m0, sstart, slen);
  f32x4 acc[4][4]; zero_acc<4>(acc);
  if (j < 3) {
    gemm_main<4>(acc, RA + (size_t)m0 * 2176 + 1536, 2176, (const bfu*)(p.ws + OFF_WQUP) + (size_t)j * 128 * 192, 192, 192, smem);
    acc_to_lds<4>(acc, smem);
    {
      const int r = tid >> 1, hf = tid & 1;
      const bfu* a = RA + (size_t)(m0 + r) * 2176 + 1536 + hf * 96;
      float ss = 0.f;
#pragma unroll
      for (int c = 0; c < 12; ++c) { float f[8]; unpack8(*(const u32x4*)(a + c * 8), f);
#pragma unroll
        for (int e = 0; e < 8; ++e) ss += f[e] * f[e]; }
      ss += __shfl_xor(ss, 1);
      if (hf == 0) rinv[r] = rsqrtf(ss * (1.f / 192.f) + 1e-6f);
    }
    __syncthreads();
#pragma unroll
    for (int it = 0; it < 8; ++it) {
      const int cid = it * 256 + tid;
      const int r = cid >> 4, c = (cid & 15) * 8;
      const int n = j * 128 + c;
      const int gc = n >> 3; const int hcc = gc % 12;
      const float ri = rinv[r];
      const int pos = m0 + r - sstart;
      float o[8];
      const float* cs = Cs + r * 132 + c;
      if (hcc < 8) {
#pragma unroll
        for (int e = 0; e < 8; ++e) o[e] = cs[e] * ri;
      } else if (hcc < 10) {
        const int i0 = (hcc - 8) * 8;
#pragma unroll
        for (int e = 0; e < 8; ++e) { const float x1 = cs[e] * ri, x2 = cs[16 + e] * ri; o[e] = x1 * rc[pos * 16 + i0 + e] - x2 * rs_[pos * 16 + i0 + e]; }
      } else {
        const int i0 = (hcc - 10) * 8;
#pragma unroll
        for (int e = 0; e < 8; ++e) { const float x2 = cs[e] * ri, x1 = cs[e - 16] * ri; o[e] = x1 * rs_[pos * 16 + i0 + e] + x2 * rc[pos * 16 + i0 + e]; }
      }
      u32x4 st; st.x = pack2(o[0], o[1]); st.y = pack2(o[2], o[3]); st.z = pack2(o[4], o[5]); st.w = pack2(o[6], o[7]);
      *(u32x4*)(Qb + (size_t)(m0 + r) * 384 + n) = st;
    }
  } else {
    const int h = j - 3;
    gemm_main<4>(acc, RA + (size_t)m0 * 2176 + 1728, 2176, (const bfu*)(p.ws + OFF_WKVUP) + (size_t)h * 128 * 128, 128, 128, smem);
    acc_to_lds<4>(acc, smem);
    {
      const int r = tid >> 1, hf = tid & 1;
      const bfu* a = RA + (size_t)(m0 + r) * 2176 + 1728 + hf * 64;
      float ss = 0.f;
#pragma unroll
      for (int c = 0; c < 8; ++c) { float f[8]; unpack8(*(const u32x4*)(a + c * 8), f);
#pragma unroll
        for (int e = 0; e < 8; ++e) ss += f[e] * f[e]; }
      ss += __shfl_xor(ss, 1);
      if (hf == 0) rinv[r] = rsqrtf(ss * (1.f / 128.f) + 1e-6f);
    }
    __syncthreads();
#pragma unroll
    for (int it = 0; it < 8; ++it) {
      const int cid = it * 256 + tid;
      const int r = cid >> 4, c = (cid & 15) * 8;
      const float ri = rinv[r];
      const float* cs = Cs + r * 132 + c;
      u32x4 st; st.x = pack2(cs[0] * ri, cs[1] * ri); st.y = pack2(cs[2] * ri, cs[3] * ri); st.z = pack2(cs[4] * ri, cs[5] * ri); st.w = pack2(cs[6] * ri, cs[7] * ri);
      if (c < 64) *(u32x4*)(Kb + (size_t)(m0 + r) * 384 + h * 96 + c) = st;
    }
#pragma unroll
    for (int it = 0; it < 4; ++it) {
      const int cid = it * 256 + tid;
      const int dd = cid & 63, r0 = (cid >> 6) * 8;
      float v[8];
#pragma unroll
      for (int e = 0; e < 8; ++e) v[e] = Cs[(r0 + e) * 132 + 64 + dd] * rinv[r0 + e];
      u32x4 st; st.x = pack2(v[0], v[1]); st.y = pack2(v[2], v[3]); st.z = pack2(v[4], v[5]); st.w = pack2(v[6], v[7]);
      *(u32x4*)(Vb + (size_t)sstart * 256 + (size_t)(h * 64 + dd) * slen + (m0 - sstart) + r0) = st;
    }
#pragma unroll
    for (int it = 0; it < 2; ++it) {
      const int cid = it * 256 + tid;
      const int r = cid >> 2, ch = cid & 3;
      const int pos = m0 + r - sstart;
      const bfu* kr = RA + (size_t)(m0 + r) * 2176 + 1856;
      const int i0 = (ch & 1) * 8;
      float x1[8], x2[8], o[8];
      unpack8(*(const u32x4*)(kr + i0), x1);
      unpack8(*(const u32x4*)(kr + 16 + i0), x2);
#pragma unroll
      for (int e = 0; e < 8; ++e) {
        const float cc = rc[pos * 16 + i0 + e], sn = rs_[pos * 16 + i0 + e];
        o[e] = (ch < 2) ? (x1[e] * cc - x2[e] * sn) : (x1[e] * sn + x2[e] * cc);
      }
      u32x4 st; st.x = pack2(o[0], o[1]); st.y = pack2(o[2], o[3]); st.z = pack2(o[4], o[5]); st.w = pack2(o[6], o[7]);
      *(u32x4*)(Kb + (size_t)(m0 + r) * 384 + h * 96 + 64 + ch * 8) = st;
    }
  }
}

template <int D, int NQ, int MODE, bool VT>
__device__ __forceinline__ void attn_item(const bfu* Q, int ldq, const bfu* Kb, int ldk, const bfu* Vb, int ldv, bfu* O, int ldo,
                          int kt0, int kt1, float sc, float m_init, int q0pos, const float* tab, unsigned char* smem) {
  constexpr int DK = (D == 64) ? 80 : 112;
  constexpr int KC = 64 * D / 8 / 256;
  constexpr int DC = D / 8;
  const int tid = get_tid(), lane = tid & 63, wave = tid >> 6, fr = lane & 15, fq = lane >> 4;
  constexpr int KSZ = 64 * DK * 2, BUFSZ = KSZ + 64 * 72 * 2;
  bf16x8 qf[NQ][D / 32];
#pragma unroll
  for (int qs = 0; qs < NQ; ++qs)
#pragma unroll
    for (int kk = 0; kk < D / 32; ++kk)
      qf[qs][kk] = *(const bf16x8*)(Q + (size_t)(wave * 16 * NQ + qs * 16 + fr) * ldq + kk * 32 + fq * 8);
  f32x4 o[NQ][4];
  float m[NQ], ls[NQ];
#pragma unroll
  for (int qs = 0; qs < NQ; ++qs) {
    m[qs] = m_init; ls[qs] = (MODE == 1 && fq == 0) ? 1.f : 0.f;
#pragma unroll
    for (int dt = 0; dt < 4; ++dt) o[qs][dt] = f32x4{0.f, 0.f, 0.f, 0.f};
  }
  u32x4 kr[KC], vr[2];
  auto load_tile = [&](int kt) {
#pragma unroll
    for (int i = 0; i < KC; ++i) { const int id = tid + 256 * i; const int row = id / DC, c = id - row * DC; kr[i] = *(const u32x4*)(Kb + (size_t)(kt * 64 + row) * ldk + c * 8); }
#pragma unroll
    for (int i = 0; i < 2; ++i) {
      const int id = tid + 256 * i; const int key = id >> 3, dc = id & 7;
      if (VT) vr[i] = *(const u32x4*)(Vb + (size_t)key * ldv + kt * 64 + dc * 8);
      else vr[i] = *(const u32x4*)(Vb + (size_t)(kt * 64 + key) * ldv + dc * 8);
    }
  };
  auto write_tile = [&](int buf) {
    bfu* Ks = (bfu*)(smem + buf * BUFSZ);
    bfu* Vt = (bfu*)(smem + buf * BUFSZ + KSZ);
#pragma unroll
    for (int i = 0; i < KC; ++i) { const int id = tid + 256 * i; const int row = id / DC, c = id - row * DC; *(u32x4*)(Ks + row * DK + c * 8) = kr[i]; }
#pragma unroll
    for (int i = 0; i < 2; ++i) {
      const int id = tid + 256 * i; const int key = id >> 3, dc = id & 7;
      if (VT) {
        *(u32x4*)(Vt + key * 72 + dc * 8) = vr[i];
      } else {
#pragma unroll
        for (int e = 0; e < 4; ++e) {
          Vt[(dc * 8 + 2 * e) * 72 + key] = (bfu)(vr[i][e] & 0xFFFFu);
          Vt[(dc * 8 + 2 * e + 1) * 72 + key] = (bfu)(vr[i][e] >> 16);
        }
      }
    }
  };
  load_tile(kt0);
  __syncthreads();
  write_tile(0);
  load_tile(min(kt0 + 1, kt1 - 1));
  __syncthreads();
  for (int kt = kt0; kt < kt1; ++kt) {
    const int cur = (kt - kt0) & 1;
    write_tile(cur ^ 1);
    load_tile(min(kt + 2, kt1 - 1));
    __builtin_amdgcn_sched_barrier(0);
    const bfu* Ks = (const bfu*)(smem + cur * BUFSZ);
    const bfu* Vt = (const bfu*)(smem + cur * BUFSZ + KSZ);
    f32x4 s[NQ][4];
#pragma unroll
    for (int qs = 0; qs < NQ; ++qs)
#pragma unroll
      for (int st = 0; st < 4; ++st) s[qs][st] = f32x4{0.f, 0.f, 0.f, 0.f};
#pragma unroll
    for (int qs = 0; qs < NQ; ++qs)
#pragma unroll
      for (int st = 0; st < 4; ++st)
#pragma unroll
        for (int kk = 0; kk < D / 32; ++kk) {
          const bf16x8 a = *(const bf16x8*)(Ks + (st * 16 + fr) * DK + kk * 32 + fq * 8);
          s[qs][st] = __builtin_amdgcn_mfma_f32_16x16x32_bf16(a, qf[qs][kk], s[qs][st], 0, 0, 0);
        }
    bf16x8 pf[NQ][2];
#pragma unroll
    for (int qs = 0; qs < NQ; ++qs) {
      const int qi = wave * 16 * NQ + qs * 16 + fr;
      float mloc = -INFINITY;
#pragma unroll
      for (int st = 0; st < 4; ++st)
#pragma unroll
        for (int j = 0; j < 4; ++j) {
          const int key = st * 16 + fq * 4 + j;
          float t = (MODE == 0) ? s[qs][st][j] : s[qs][st][j] * sc;
          if (MODE == 1) {
            const int rel = kt * 64 + key - (q0pos + qi);
            const bool valid = (rel >= -128) && (rel <= 128);
            const int ri = min(max(rel + 128, 0), 256);
            t = valid ? t + tab[ri] : -1e30f;
          } else if (MODE == 2) {
            const int c = qi;
            const int cs = min(max(c - 8, 0), 48);
            const bool valid = (key >= cs) && (key < cs + 16);
            const int dr = kt - (q0pos >> 6) + 7;
            const int dc = min(max(key - c + 15, 0), 30);
            t = valid ? t + tab[dr * 31 + dc] : -1e30f;
          }
          s[qs][st][j] = t;
          mloc = fmaxf(mloc, t);
        }
      mloc = fmaxf(mloc, __shfl_xor(mloc, 16));
      mloc = fmaxf(mloc, __shfl_xor(mloc, 32));
      if (MODE == 0) mloc *= sc;
      const float mn = fmaxf(m[qs], mloc);
      const float alpha = __builtin_amdgcn_exp2f(m[qs] - mn);
      m[qs] = mn;
      float psum = 0.f;
#pragma unroll
      for (int st = 0; st < 4; ++st)
#pragma unroll
        for (int j = 0; j < 4; ++j) {
          const float pv = __builtin_amdgcn_exp2f((MODE == 0) ? __builtin_fmaf(s[qs][st][j], sc, -mn) : s[qs][st][j] - mn);
          psum += pv; s[qs][st][j] = pv;
        }
      ls[qs] = ls[qs] * alpha + psum;
#pragma unroll
      for (int dt = 0; dt < 4; ++dt)
#pragma unroll
        for (int j = 0; j < 4; ++j) o[qs][dt][j] *= alpha;
#pragma unroll
      for (int k2 = 0; k2 < 2; ++k2) {
        union { bf16x8 v; u32x4 u; } pk;
        pk.u = u32x4{pack2(s[qs][2 * k2][0], s[qs][2 * k2][1]), pack2(s[qs][2 * k2][2], s[qs][2 * k2][3]),
                     pack2(s[qs][2 * k2 + 1][0], s[qs][2 * k2 + 1][1]), pack2(s[qs][2 * k2 + 1][2], s[qs][2 * k2 + 1][3])};
        pf[qs][k2] = pk.v;
      }
#pragma unroll
      for (int dt = 0; dt < 4; ++dt)
#pragma unroll
        for (int k2 = 0; k2 < 2; ++k2) {
          const u32x2 h0 = *(const u32x2*)(Vt + (dt * 16 + fr) * 72 + k2 * 32 + fq * 4);
          const u32x2 h1 = *(const u32x2*)(Vt + (dt * 16 + fr) * 72 + k2 * 32 + 16 + fq * 4);
          union { bf16x8 v; u32x4 u; } av;
          av.u = u32x4{h0[0], h0[1], h1[0], h1[1]};
          o[qs][dt] = __builtin_amdgcn_mfma_f32_16x16x32_bf16(av.v, pf[qs][k2], o[qs][dt], 0, 0, 0);
        }
    }
    __syncthreads();
  }
#pragma unroll
  for (int qs = 0; qs < NQ; ++qs) {
    float l = ls[qs];
    l += __shfl_xor(l, 16);
    l += __shfl_xor(l, 32);
    const float inv = __builtin_amdgcn_rcpf(l);
    const int qi = wave * 16 * NQ + qs * 16 + fr;
#pragma unroll
    for (int dt = 0; dt < 4; ++dt) {
      u32x2 st; st.x = pack2(o[qs][dt][0] * inv, o[qs][dt][1] * inv); st.y = pack2(o[qs][dt][2] * inv, o[qs][dt][3] * inv);
      *(u32x2*)(O + (size_t)qi * ldo + dt * 16 + fq * 4) = st;
    }
  }
}

constexpr int ATT_TAB_OFF = 2 * (64 * 112 * 2 + 64 * 72 * 2);

__device__ __forceinline__ void swa_item(const Params& p, int l, int x, unsigned char* smem) {
  const int gt = x >> 2, h = x & 3;
  const int t0 = gt * 128;
  int sstart, slen; seq_of_token(t0, sstart, slen);
  const int q0 = t0 - sstart; const int qt = q0 >> 7;
  float* tab = (float*)(smem + ATT_TAB_OFF);
  __syncthreads();
  for (int i = get_tid(); i < 257; i += 256) tab[i] = ((const float*)(p.ws + OFF_T5))[h * 257 + i];
  bfu* RA = (bfu*)(p.ws + OFF_RA);
  const int kt0 = max(0, qt * 2 - 2), kt1 = min(slen >> 6, qt * 2 + 4);
  const float sink = p.in[19][l * 4 + h] * LOG2E;
  attn_item<64, 2, 1, false>(RA + (size_t)t0 * 2176 + 256 + h * 64, 2176,
                      RA + (size_t)sstart * 2176 + 512 + (h >> 1) * 64, 2176,
                      RA + (size_t)sstart * 2176 + 640 + (h >> 1) * 64, 2176,
                      RA + (size_t)t0 * 2176 + 256 + h * 64, 2176, kt0, kt1, 0.125f * LOG2E, sink, q0, tab, smem);
}
__device__ __forceinline__ void na_item(const Params& p, int l, int x, unsigned char* smem) {
  const int gt = x >> 2, h = x & 3;
  const int t0 = gt * 64;
  int sstart, slen; seq_of_token(t0, sstart, slen);
  const int q0 = t0 - sstart; const int r = q0 >> 6; const int rows = slen >> 6;
  const int rs = min(max(r - 4, 0), rows - 8);
  float* tab = (float*)(smem + ATT_TAB_OFF);
  __syncthreads();
  for (int i = get_tid(); i < 465; i += 256) tab[i] = p.in[21][(size_t)(l * 4 + h) * 465 + i] * LOG2E;
  bfu* RA = (bfu*)(p.ws + OFF_RA);
  attn_item<64, 1, 2, false>(RA + (size_t)t0 * 2176 + 768 + h * 64, 2176,
                      RA + (size_t)sstart * 2176 + 1024 + h * 64, 2176,
                      RA + (size_t)sstart * 2176 + 1280 + h * 64, 2176,
                      RA + (size_t)t0 * 2176 + 768 + h * 64, 2176, rs, rs + 8, 0.125f * LOG2E, -INFINITY, q0, tab, smem);
}
__device__ __forceinline__ void memattn_item(const Params& p, int x, unsigned char* smem) {
  const int gt = x >> 2, h = x & 3;
  const int t0 = gt * 128;
  const int seq = (t0 < 16384) ? (t0 >> 13) : (2 + ((t0 - 16384) >> 12));
  bfu* RA = (bfu*)(p.ws + OFF_RA);
  const bfu* MKV = (const bfu*)(p.ws + OFF_MEMKV) + (size_t)seq * 256 * 512;
  attn_item<64, 2, 0, false>(RA + (size_t)t0 * 2176 + 1888 + h * 64, 2176, MKV + h * 64, 512, MKV + 256 + h * 64, 512,
                      RA + (size_t)t0 * 2176 + 1888 + h * 64, 2176, 0, 4, 0.125f * LOG2E, -INFINITY, 0, nullptr, smem);
}
__device__ __forceinline__ void mla_item(const Params& p, int x, unsigned char* smem) {
  const int gt = x >> 2, h = x & 3;
  const int t0 = gt * 128;
  int sstart, slen; seq_of_token(t0, sstart, slen);
  const bfu* Qb = (const bfu*)(p.ws + OFF_RC);
  const bfu* Kb = Qb + (size_t)T * 384;
  const bfu* Vb = Qb + (size_t)T * 768;
  bfu* RA = (bfu*)(p.ws + OFF_RA);
  attn_item<96, 2, 0, true>(Qb + (size_t)t0 * 384 + h * 96, 384, Kb + (size_t)sstart * 384 + h * 96, 384, Vb + (size_t)sstart * 256 + (size_t)h * 64 * slen, slen,
                      RA + (size_t)t0 * 2176 + 1536 + h * 64, 2176, 0, slen >> 6, 0.10206207261596575f * LOG2E, -INFINITY, 0, nullptr, smem);
}

__device__ __forceinline__ void glu_item(const Params& p, int x, unsigned char* smem) {
  bfu* RA = (bfu*)(p.ws + OFF_RA);
  const bfu* W = (const bfu*)(p.ws + OFF_WGLU);
  const int mt = x >> 1, nt = x & 1;
  bfu* rows = RA + (size_t)mt * 128 * 2176;
  f32x4 acc[4][4];
  zero_acc<4>(acc);
  gemm_main<4>(acc, rows, 2176, W + (size_t)nt * 128 * 256, 256, 256, smem);
  acc_to_lds<4>(acc, smem);
  const float* Cs = (const float*)smem;
#pragma unroll
  for (int it = 0; it < 8; ++it) {
    const int cid = it * 256 + get_tid();
    const int r = cid >> 4, c = (cid & 15) * 8;
    const bfu* gp = rows + (size_t)r * 2176 + nt * 128 + c;
    float g[8]; unpack8(*(const u32x4*)gp, g);
    const float* cs = Cs + r * 132 + c;
    float o[8];
#pragma unroll
    for (int e = 0; e < 8; ++e) o[e] = g[e] * sigmoidf_(cs[e]);
    u32x4 st; st.x = pack2(o[0], o[1]); st.y = pack2(o[2], o[3]); st.z = pack2(o[4], o[5]); st.w = pack2(o[6], o[7]);
    *(u32x4*)(rows + (size_t)r * 2176 + 512 + nt * 128 + c) = st;
  }
}

__device__ __forceinline__ void phase_merge(const Params& p, unsigned char* smem) {
  constexpr int ASZ = 256 * 64, BSZ = 128 * 64, STG = ASZ + BSZ;
  constexpr int NS = 200;
  const bfu* XN = (const bfu*)(p.ws + OFF_XN);
  const bfu* RA = (const bfu*)(p.ws + OFF_RA);
  const bfu* WG = (const bfu*)(p.ws + OFF_WING);
  const bfu* WB = (const bfu*)(p.ws + OFF_WBR);
  bfu* MG = (bfu*)(p.ws + OFF_RC);
  const int Mt = T / 256, Nt = 8;
  FOR_TILES(id, Mt * Nt) {
    int mt, nt; tile_mn(id, Mt, Nt, mt, nt);
    const int tid = get_tid512(), lane = tid & 63, wave = tid >> 6, fr = lane & 15, fq = lane >> 4, wm = wave >> 1, wn = wave & 1;
    const int lrow = lane >> 2;
    const int lchunk = (lane & 3) ^ ((lane >> 4) & 2);
    const int rd_off = fr * 64 + ((fq ^ ((fr >> 2) & 2)) << 4);
    const unsigned arow = (unsigned)(mt * 256 + wave * 32 + lrow);
    const unsigned brow = (unsigned)(nt * 128 + wave * 16 + lrow);
    const unsigned aoX = arow * 1024u + lchunk * 8, aoR = arow * 2176u + lchunk * 8, boG = brow * 1024u + lchunk * 8, boB = brow * 256u + lchunk * 8;
    f32x4 accO[4][4], acc[4][4];
    u32x4* gpl = (u32x4*)(smem + 73728) + tid;
#pragma unroll
    for (int mi = 0; mi < 4; ++mi)
#pragma unroll
      for (int ni = 0; ni < 4; ++ni) { accO[mi][ni] = f32x4{0.f, 0.f, 0.f, 0.f}; acc[mi][ni] = f32x4{0.f, 0.f, 0.f, 0.f}; }
    asm volatile("s_waitcnt vmcnt(0)" ::: "memory");
    __syncthreads();
#define MG_ISSUE(s_, stg_)                                                                                                        \
    {                                                                                                                               \
      const int bb_ = (s_) / 40, rr_ = (s_) - bb_ * 40;                                                                             \
      const bool gate_ = rr_ < 32;                                                                                                  \
      const int kk_ = gate_ ? rr_ : rr_ - 32;                                                                                       \
      const int coff_ = (bb_ == 0) ? 512 : (bb_ == 1) ? 256 : (bb_ == 2) ? 768 : (bb_ == 3) ? 1536 : 1888;                           \
      const bfu* ap_ = gate_ ? (XN + kk_ * 32) + aoX : (RA + coff_ + kk_ * 32) + aoR;                                                \
      const unsigned as_ = gate_ ? 16u * 1024u : 16u * 2176u;                                                                         \
      const bfu* bp_ = gate_ ? (WG + (size_t)bb_ * 1024 * 1024 + kk_ * 32) + boG : (WB + (size_t)bb_ * 1024 * 256 + kk_ * 32) + boB;  \
      unsigned char* sb_ = smem + (stg_) * STG;                                                                                     \
      __builtin_amdgcn_global_load_lds((const unsigned*)ap_, (__attribute__((address_space(3))) unsigned*)(sb_ + (wave * 32) * 64), 16, 0, 0);           \
      __builtin_amdgcn_global_load_lds((const unsigned*)(ap_ + as_), (__attribute__((address_space(3))) unsigned*)(sb_ + (wave * 32 + 16) * 64), 16, 0, 0); \
      __builtin_amdgcn_global_load_lds((const unsigned*)bp_, (__attribute__((address_space(3))) unsigned*)(sb_ + ASZ + (wave * 16) * 64), 16, 0, 0);      \
    }
    MG_ISSUE(0, 0);
    MG_ISSUE(1, 1);
    int stg = 0, sidx = 0;
#define MG_STEP()                                                                                          \
    {                                                                                                        \
      if (sidx + 1 < NS) asm volatile("s_waitcnt vmcnt(3)" ::: "memory");                                    \
      else asm volatile("s_waitcnt vmcnt(0)" ::: "memory");                                                  \
      asm volatile("s_waitcnt lgkmcnt(0)" ::: "memory");                                                     \
      __builtin_amdgcn_s_barrier();                                                                          \
      if (sidx + 2 < NS) {                                                                                   \
        const int s2 = (stg >= 1) ? stg - 1 : 2;                                                             \
        MG_ISSUE(sidx + 2, s2);                                                                              \
      }                                                                                                      \
      const unsigned char* Ac = smem + stg * STG + rd_off;                                                   \
      const unsigned char* Bc = Ac + ASZ;                                                                    \
      bf16x8 bfv[4];                                                                                         \
      _Pragma("unroll") for (int ni = 0; ni < 4; ++ni) bfv[ni] = *(const bf16x8*)(Bc + (wn * 64 + ni * 16) * 64); \
      _Pragma("unroll") for (int mi = 0; mi < 4; ++mi) {                                                     \
        const bf16x8 a0 = *(const bf16x8*)(Ac + (wm * 64 + mi * 16) * 64);                                   \
        _Pragma("unroll") for (int ni = 0; ni < 4; ++ni)                                                     \
          acc[mi][ni] = __builtin_amdgcn_mfma_f32_16x16x32_bf16(a0, bfv[ni], acc[mi][ni], 0, 0, 0);          \
      }                                                                                                      \
      stg = (stg == 2) ? 0 : stg + 1;                                                                        \
      ++sidx;                                                                                                \
    }
#pragma unroll 1
    for (int b = 0; b < 5; ++b) {
#pragma unroll 1
      for (int k = 0; k < 32; ++k) MG_STEP()
#pragma unroll
      for (int mi = 0; mi < 4; ++mi)
#pragma unroll
        for (int nh = 0; nh < 2; ++nh) {
          u32x4 g4;
          g4.x = pack2(sigmoidf_(acc[mi][2 * nh][0]), sigmoidf_(acc[mi][2 * nh][1]));
          g4.y = pack2(sigmoidf_(acc[mi][2 * nh][2]), sigmoidf_(acc[mi][2 * nh][3]));
          g4.z = pack2(sigmoidf_(acc[mi][2 * nh + 1][0]), sigmoidf_(acc[mi][2 * nh + 1][1]));
          g4.w = pack2(sigmoidf_(acc[mi][2 * nh + 1][2]), sigmoidf_(acc[mi][2 * nh + 1][3]));
          gpl[(mi * 2 + nh) * 512] = g4;
          acc[mi][2 * nh] = f32x4{0.f, 0.f, 0.f, 0.f}; acc[mi][2 * nh + 1] = f32x4{0.f, 0.f, 0.f, 0.f};
        }
#pragma unroll 1
      for (int k = 0; k < 8; ++k) MG_STEP()
#pragma unroll
      for (int mi = 0; mi < 4; ++mi)
#pragma unroll
        for (int nh = 0; nh < 2; ++nh) {
          const u32x4 g4 = gpl[(mi * 2 + nh) * 512];
          accO[mi][2 * nh][0] += bflo(g4.x) * acc[mi][2 * nh][0];
          accO[mi][2 * nh][1] += bfhi(g4.x) * acc[mi][2 * nh][1];
          accO[mi][2 * nh][2] += bflo(g4.y) * acc[mi][2 * nh][2];
          accO[mi][2 * nh][3] += bfhi(g4.y) * acc[mi][2 * nh][3];
          accO[mi][2 * nh + 1][0] += bflo(g4.z) * acc[mi][2 * nh + 1][0];
          accO[mi][2 * nh + 1][1] += bfhi(g4.z) * acc[mi][2 * nh + 1][1];
          accO[mi][2 * nh + 1][2] += bflo(g4.w) * acc[mi][2 * nh + 1][2];
          accO[mi][2 * nh + 1][3] += bfhi(g4.w) * acc[mi][2 * nh + 1][3];
          acc[mi][2 * nh] = f32x4{0.f, 0.f, 0.f, 0.f}; acc[mi][2 * nh + 1] = f32x4{0.f, 0.f, 0.f, 0.f};
        }
    }
#undef MG_STEP
#undef MG_ISSUE
    __syncthreads();
    float* Cs = (float*)smem;
#pragma unroll
    for (int mi = 0; mi < 4; ++mi)
#pragma unroll
      for (int ni = 0; ni < 4; ++ni)
#pragma unroll
        for (int j = 0; j < 4; ++j) Cs[(wm * 64 + mi * 16 + fq * 4 + j) * 132 + wn * 64 + ni * 16 + fr] = accO[mi][ni][j];
    __syncthreads();
#pragma unroll
    for (int it = 0; it < 8; ++it) {
      const int cid = it * 512 + tid;
      const int r = cid >> 4, c = (cid & 15) * 8;
      const float* cs = Cs + r * 132 + c;
      u32x4 st; st.x = pack2(cs[0], cs[1]); st.y = pack2(cs[2], cs[3]); st.z = pack2(cs[4], cs[5]); st.w = pack2(cs[6], cs[7]);
      *(u32x4*)(MG + (size_t)(mt * 256 + r) * 1024 + nt * 128 + c) = st;
    }
  }
}

constexpr int NPH = 14;

template <int ph>
__device__ __forceinline__ void run_phase(const Params& p, int l, unsigned char* smem_raw) {
  unsigned char* smem = smem_raw + vb_id() * LDS_HALF;
  switch (ph) {
    case 0: phase_prep(p, l, smem); break;
    case 1: phase_ffn_gu(p, 0, smem_raw); break;
    case 2: phase_resid_gemm(p, (const bfu*)(p.ws + OFF_RA), 2816, 2816, (const bfu*)(p.ws + OFF_WD1), 0.5f, smem_raw); break;
    case 3:
      for (int w = VBLK; w < T / 4; w += VGRID) norm_rows_phase(p, p.in[8] + l * 1024, 0, w);
      break;
    case 4: phase_inproj(p, smem_raw); break;
    case 5: {
      const int n1 = (T / 128) * 7, n2 = 1024;
      for (int w = VBLK; w < n1 + n2; w += VGRID) {
        if (w < n1) mla_prep_tile(p, w, smem); else s5_item<false>(p, l, w - n1, smem);
      }
    } break;
    case 6: {
      const int nmla = 1024, nb = 48, nswa = 1024, nna = 2048, nmem = 1024;
      for (int w = VBLK; w < nmla + nb + nswa + nna + nmem; w += VGRID) {
        int x = w;
        if (x < nmla) { mla_item(p, x, smem); continue; }
        x -= nmla;
        if (x < nb) { s5b_item(p, x); continue; }
        x -= nb;
        if (x < nswa) { swa_item(p, l, x, smem); continue; }
        x -= nswa;
        if (x < nna) { na_item(p, l, x, smem); continue; }
        x -= nna;
        memattn_item(p, x, smem);
      }
    } break;
    case 7: break;
    case 15:
      for (int w = VBLK; w < 1024; w += VGRID) s5_item<true>(p, l, w, smem);
      break;
    case 8:
      for (int w = VBLK; w < T / 64; w += VGRID) glu_item(p, w, smem);
      break;
    case 9: phase_merge(p, smem_raw); break;
    case 10: phase_resid_gemm(p, (const bfu*)(p.ws + OFF_RC), 1024, 1024, (const bfu*)(p.ws + OFF_WOUT), 1.0f, smem_raw); break;
    case 11:
      for (int w = VBLK; w < T / 4; w += VGRID) norm_rows_phase(p, p.in[30] + l * 1024, 0, w);
      break;
    case 12: phase_ffn_gu(p, 1, smem_raw); break;
    case 13: phase_resid_gemm(p, (const bfu*)(p.ws + OFF_RA), 2816, 2816, (const bfu*)(p.ws + OFF_WD2), 0.5f, smem_raw); break;
    default: {
      for (int w = VBLK; w < T / 4; w += VGRID) {
        const int row = w * 4 + (get_tid() >> 6);
        float* hp = p.out + (size_t)row * 1024;
        rms_row(hp, p.in[34], nullptr, nullptr, hp);
      }
    } break;
  }
}

#if MEGA
__device__ __forceinline__ void gbar(unsigned* ctr, unsigned target) {
  __syncthreads();
  if (threadIdx.x == 0) {
    __builtin_amdgcn_fence(__ATOMIC_RELEASE, "agent");
    __hip_atomic_fetch_add(ctr, 1u, __ATOMIC_RELAXED, __HIP_MEMORY_SCOPE_AGENT);
    while (__hip_atomic_load(ctr, __ATOMIC_RELAXED, __HIP_MEMORY_SCOPE_AGENT) < target) __builtin_amdgcn_s_sleep(2);
    __builtin_amdgcn_fence(__ATOMIC_ACQUIRE, "agent");
  }
  __syncthreads();
}
__global__ void __launch_bounds__(512, 2) k_mega(Params p) {
  extern __shared__ __attribute__((aligned(16))) unsigned char smem[];
  cg::grid_group grid = cg::this_grid();
  unsigned nbar = 0;
  unsigned* bar_ctr = (unsigned*)(p.ws + OFF_BAR);
  {
    constexpr int l = 0;
#define PHS1(k) { const Params* pp = (const Params*)__builtin_amdgcn_kernarg_segment_ptr(); asm volatile("" : "+s"(pp)); const Params q = *pp; run_phase<k>(q, l, smem); } if (nbar == 0) { grid.sync(); nbar = 1; } else { gbar(bar_ctr, nbar * gridDim.x); ++nbar; }
#define PHS(k) PHS1(k) if (k == PROBE_PH) { _Pragma("unroll 1") for (int rep = 0; rep < PROBE_N; ++rep) { PHS1(k) } }
    PHS(0) PHS(1) PHS(2) PHS(3) PHS(4) PHS(5) PHS(6) PHS(15) PHS(8) PHS(9) PHS(10) PHS(11) PHS(12) PHS(13)
  }
  {
    constexpr int l = 1;
    PHS(0) PHS(1) PHS(2) PHS(3) PHS(4) PHS(5) PHS(6) PHS(15) PHS(8) PHS(9) PHS(10) PHS(11) PHS(12) PHS(13)
#undef PHS
  }
  { const Params* pp = (const Params*)__builtin_amdgcn_kernarg_segment_ptr(); asm volatile("" : "+s"(pp)); const Params q = *pp; run_phase<NPH>(q, 0, smem); }
}

#endif

template <int PH>
__global__ void __launch_bounds__(512, 2) k_phase(Params p, int l) {
  extern __shared__ __attribute__((aligned(16))) unsigned char smem[];
  run_phase<PH>(p, l, smem);
}
template <int PH>
static void launch_phase(const Params& p, int l, int grid, hipStream_t stream) {
  static bool attr = false;
  if (!attr) { hipFuncSetAttribute((const void*)k_phase<PH>, hipFuncAttributeMaxDynamicSharedMemorySize, LDS_BYTES); attr = true; }
  hipLaunchKernelGGL(k_phase<PH>, dim3(grid), dim3(512), LDS_BYTES, stream, p, l);
}

extern "C" void kernel_launch(void* const* d_in, const int* in_sizes, int n_in, void* d_out, int out_size, void* d_ws,
                              size_t ws_size, hipStream_t stream) {
  static int grid_blocks = 0;
  if (!grid_blocks) {
    int dev = 0, cus = 0, per_cu = 0;
    hipGetDevice(&dev);
    hipDeviceGetAttribute(&cus, hipDeviceAttributeMultiprocessorCount, dev);
#if MEGA
    hipFuncSetAttribute((const void*)k_mega, hipFuncAttributeMaxDynamicSharedMemorySize, LDS_BYTES);
    hipOccupancyMaxActiveBlocksPerMultiprocessor(&per_cu, k_mega, 512, LDS_BYTES);
#else
    per_cu = 1;
#endif
    per_cu = 1;
    if (cus <= 0) cus = 256;
    grid_blocks = cus * per_cu;
    if (ws_size < WS_END) fprintf(stderr, "kernel_launch: workspace too small: %zu < %zu\n", ws_size, (size_t)WS_END);
  }
  Params p{};
  for (int i = 0; i < 35; ++i) p.in[i] = (const float*)d_in[i];
  p.out = (float*)d_out;
  p.ws = (unsigned char*)d_ws;
#if MEGA
  hipMemsetAsync((char*)d_ws + OFF_BAR, 0, 256, stream);
  void* args[] = {&p};
  hipError_t e = hipLaunchCooperativeKernel((void*)k_mega, dim3(grid_blocks), dim3(512), args, LDS_BYTES, stream);
  if (e != hipSuccess) fprintf(stderr, "cooperative launch failed: %s (grid %d)\n", hipGetErrorString(e), grid_blocks);
#else
  for (int l = 0; l < 2; ++l) {
#define LP(k) launch_phase<k>(p, l, grid_blocks, stream);
    LP(0) LP(1) LP(2) LP(3) LP(4) LP(5) LP(6) LP(15) LP(8) LP(9) LP(10) LP(11) LP(12) LP(13)
#undef LP
  }
  launch_phase<NPH>(p, 0, grid_blocks, stream);
#endif
}
```

```cpp
#include <hip/hip_runtime.h>
#include <hip/hip_cooperative_groups.h>
#include <cstdio>
#include <cstdint>
namespace cg = cooperative_groups;

#ifndef PROBE_PH
#define PROBE_PH 99
#define PROBE_N 0
#endif
#ifndef MEGA
#define MEGA 1
#endif

typedef unsigned short bfu;
using bf16x8 = __attribute__((ext_vector_type(8))) short;
using f32x4 = __attribute__((ext_vector_type(4))) float;
using u32x4 = __attribute__((ext_vector_type(4))) unsigned;
using u32x2 = __attribute__((ext_vector_type(2))) unsigned;

constexpr int T = 32768;
constexpr int LDS_HALF = 73728;
constexpr int LDS_BYTES = 2 * LDS_HALF;
constexpr float LOG2E = 1.4426950408889634f;

constexpr size_t SZ_WGU = 5632ull * 1024 * 2;
constexpr size_t SZ_WD = 1024ull * 2816 * 2;
constexpr size_t OFF_WGU1 = 0;
constexpr size_t OFF_WD1 = OFF_WGU1 + SZ_WGU;
constexpr size_t OFF_WGU2 = OFF_WD1 + SZ_WD;
constexpr size_t OFF_WD2 = OFF_WGU2 + SZ_WGU;
constexpr size_t OFF_WINA = OFF_WD2 + SZ_WD;
constexpr size_t OFF_WING = OFF_WINA + 2304ull * 1024 * 2;
constexpr size_t OFF_WBR = OFF_WING + 5120ull * 1024 * 2;
constexpr size_t OFF_WOUT = OFF_WBR + 5ull * 1024 * 256 * 2;
constexpr size_t OFF_WMEM = OFF_WOUT + 1024ull * 1024 * 2;
constexpr size_t OFF_WGLU = OFF_WMEM + 512ull * 1024 * 2;
constexpr size_t OFF_WQUP = OFF_WGLU + 256ull * 256 * 2;
constexpr size_t OFF_WKVUP = OFF_WQUP + 384ull * 192 * 2;
constexpr size_t OFF_XN = OFF_WKVUP + 512ull * 128 * 2;
constexpr size_t OFF_RA = OFF_XN + (size_t)T * 1024 * 2;
constexpr size_t OFF_RC = OFF_RA + (size_t)T * 2176 * 2;
constexpr size_t OFF_MEMN = OFF_RC + (size_t)T * 1024 * 2;
constexpr size_t OFF_MEMKV = OFF_MEMN + 1536ull * 1024 * 2;
constexpr size_t OFF_S5E = OFF_MEMKV + 1536ull * 512 * 2;
constexpr size_t OFF_SA = OFF_S5E + 1024ull * 2048 * 8;
constexpr size_t OFF_SAP = OFF_SA + 2048 * 8;
constexpr size_t OFF_SBB = OFF_SAP + 2048 * 8;
constexpr size_t OFF_ROPE = OFF_SBB + 2048ull * 16 * 8;
constexpr size_t OFF_T5 = OFF_ROPE + 8192ull * 16 * 4 * 2;
constexpr size_t OFF_BBH = OFF_T5 + 8192;
constexpr size_t OFF_CCH = OFF_BBH + 131072;
constexpr size_t OFF_WEND = OFF_CCH + 131072;
constexpr size_t OFF_BAR = OFF_WEND + 2ull * 16 * 128 * 512 * 2;
constexpr size_t WS_END = OFF_BAR + 256;

struct Params {
  const float* in[35];
  float* out;
  unsigned char* ws;
};

__device__ __forceinline__ int get_tid() { int t = threadIdx.x & 255; asm volatile("" : "+v"(t)); return t; }
__device__ __forceinline__ int get_tid512() { int t = threadIdx.x; asm volatile("" : "+v"(t)); return t; }
__device__ __forceinline__ int vb_id() { return __builtin_amdgcn_readfirstlane((int)(threadIdx.x >> 8)); }
#define VBLK ((int)blockIdx.x * 2 + vb_id())
#define VGRID ((int)gridDim.x * 2)
typedef __bf16 hbf16x2 __attribute__((ext_vector_type(2)));
typedef float hf32x2 __attribute__((ext_vector_type(2)));
__device__ __forceinline__ unsigned pack2(float a, float b) {
  const hf32x2 v = {a, b};
  const hbf16x2 h = __builtin_convertvector(v, hbf16x2);
  return __builtin_bit_cast(unsigned, h);
}
__device__ __forceinline__ unsigned short f2bf(float f) { return (unsigned short)(pack2(f, 0.f) & 0xFFFFu); }
__device__ __forceinline__ float bf2f(unsigned short b) { return __uint_as_float(((unsigned)b) << 16); }
__device__ __forceinline__ float bflo(unsigned u) { return __uint_as_float(u << 16); }
__device__ __forceinline__ float bfhi(unsigned u) { return __uint_as_float(u & 0xFFFF0000u); }
__device__ __forceinline__ float wave_sum(float v) {
#pragma unroll
  for (int o = 32; o > 0; o >>= 1) v += __shfl_xor(v, o);
  return v;
}
__device__ __forceinline__ float sigmoidf_(float x) { return __builtin_amdgcn_rcpf(1.f + __expf(-x)); }
__device__ __forceinline__ float geluf_(float x) {
  float z = 0.7978845608028654f * (x + 0.044715f * x * x * x);
  float th = 1.f - 2.f * __builtin_amdgcn_rcpf(1.f + __expf(2.f * z));
  return 0.5f * x * (1.f + th);
}
__device__ __forceinline__ void seq_of_token(int t, int& start, int& len) {
  if (t < 16384) { start = t & ~8191; len = 8192; }
  else { start = 16384 + ((t - 16384) & ~4095); len = 4096; }
}
__device__ __forceinline__ void unpack8(const u32x4& u, float* f) {
  f[0] = bflo(u.x); f[1] = bfhi(u.x); f[2] = bflo(u.y); f[3] = bfhi(u.y);
  f[4] = bflo(u.z); f[5] = bfhi(u.z); f[6] = bflo(u.w); f[7] = bfhi(u.w);
}

template <int WN>
__device__ __forceinline__ void gemm_main(f32x4 (&acc)[4][WN], const bfu* A, int lda, const bfu* B, int ldb, int K,
                                          unsigned char* smem) {
  constexpr int BN = 32 * WN;
  constexpr int NB = BN / 32;
  constexpr int RS = (WN == 2) ? 160 : 144;
  constexpr int ASZ = 128 * RS, BSZ = BN * RS;
  const int tid = get_tid(), lane = tid & 63, wave = tid >> 6, fr = lane & 15, fq = lane >> 4, wm = wave >> 1, wn = wave & 1;
  unsigned char* As = smem;
  unsigned char* Bs = smem + 2 * ASZ;
  const int lr = tid >> 3, lc = tid & 7;
  u32x4 ra[4], rb[NB];
  const bfu* Ap = A + (size_t)lr * lda + lc * 8;
  const bfu* Bp = B + (size_t)lr * ldb + lc * 8;
  const int nk = K >> 6;
#pragma unroll
  for (int i = 0; i < 4; ++i) ra[i] = *(const u32x4*)(Ap + (size_t)i * 32 * lda);
#pragma unroll
  for (int i = 0; i < NB; ++i) rb[i] = *(const u32x4*)(Bp + (size_t)i * 32 * ldb);
  __syncthreads();
#pragma unroll
  for (int i = 0; i < 4; ++i) *(u32x4*)(As + (lr + 32 * i) * RS + lc * 16) = ra[i];
#pragma unroll
  for (int i = 0; i < NB; ++i) *(u32x4*)(Bs + (lr + 32 * i) * RS + lc * 16) = rb[i];
  __syncthreads();
  for (int kt = 0; kt < nk; ++kt) {
    const int cur = kt & 1;
    {
      const int kn = min(kt + 1, nk - 1);
      const bfu* Ap2 = Ap + kn * 64;
      const bfu* Bp2 = Bp + kn * 64;
#pragma unroll
      for (int i = 0; i < 4; ++i) ra[i] = *(const u32x4*)(Ap2 + (size_t)i * 32 * lda);
#pragma unroll
      for (int i = 0; i < NB; ++i) rb[i] = *(const u32x4*)(Bp2 + (size_t)i * 32 * ldb);
    }
    __builtin_amdgcn_sched_barrier(0);
    const unsigned char* Ac = As + cur * ASZ;
    const unsigned char* Bc = Bs + cur * BSZ;
#pragma unroll
    for (int kk = 0; kk < 2; ++kk) {
      bf16x8 af[4], bfv[WN];
#pragma unroll
      for (int mi = 0; mi < 4; ++mi) af[mi] = *(const bf16x8*)(Ac + (wm * 64 + mi * 16 + fr) * RS + kk * 64 + fq * 16);
#pragma unroll
      for (int ni = 0; ni < WN; ++ni) bfv[ni] = *(const bf16x8*)(Bc + (wn * 16 * WN + ni * 16 + fr) * RS + kk * 64 + fq * 16);
#pragma unroll
      for (int mi = 0; mi < 4; ++mi)
#pragma unroll
        for (int ni = 0; ni < WN; ++ni) acc[mi][ni] = __builtin_amdgcn_mfma_f32_16x16x32_bf16(af[mi], bfv[ni], acc[mi][ni], 0, 0, 0);
    }
    {
      unsigned char* An = As + (cur ^ 1) * ASZ;
      unsigned char* Bn = Bs + (cur ^ 1) * BSZ;
#pragma unroll
      for (int i = 0; i < 4; ++i) *(u32x4*)(An + (lr + 32 * i) * RS + lc * 16) = ra[i];
#pragma unroll
      for (int i = 0; i < NB; ++i) *(u32x4*)(Bn + (lr + 32 * i) * RS + lc * 16) = rb[i];
    }
    __syncthreads();
  }
}

__device__ __forceinline__ void gemm_s5a(f32x4 (&acc)[4][4], const bfu* A, const bfu* B, int ldb, unsigned char* smem) {
  constexpr int WN = 4;
  constexpr int K = 512;
  const size_t lda = (size_t)32 * 2176;
  constexpr int BN = 32 * WN;
  constexpr int NB = BN / 32;
  constexpr int RS = (WN == 2) ? 160 : 144;
  constexpr int ASZ = 128 * RS, BSZ = BN * RS;
  const int tid = get_tid(), lane = tid & 63, wave = tid >> 6, fr = lane & 15, fq = lane >> 4, wm = wave >> 1, wn = wave & 1;
  unsigned char* As = smem;
  unsigned char* Bs = smem + 2 * ASZ;
  const int lr = tid >> 3, lc = tid & 7;
  u32x4 ra[4], rb[NB];
  const bfu* Ap = A + (size_t)lr * lda + (lc >> 1) * 2176 + (lc & 1) * 8;
  const bfu* Bp = B + (size_t)lr * ldb + lc * 8;
  const int nk = K >> 6;
#pragma unroll
  for (int i = 0; i < 4; ++i) ra[i] = *(const u32x4*)(Ap + (size_t)i * 32 * lda);
#pragma unroll
  for (int i = 0; i < NB; ++i) rb[i] = *(const u32x4*)(Bp + (size_t)i * 32 * ldb);
  __syncthreads();
#pragma unroll
  for (int i = 0; i < 4; ++i) *(u32x4*)(As + (lr + 32 * i) * RS + lc * 16) = ra[i];
#pragma unroll
  for (int i = 0; i < NB; ++i) *(u32x4*)(Bs + (lr + 32 * i) * RS + lc * 16) = rb[i];
  __syncthreads();
  for (int kt = 0; kt < nk; ++kt) {
    const int cur = kt & 1;
    {
      const int kn = min(kt + 1, nk - 1);
      const bfu* Ap2 = Ap + (size_t)kn * (4 * 2176);
      const bfu* Bp2 = Bp + kn * 64;
#pragma unroll
      for (int i = 0; i < 4; ++i) ra[i] = *(const u32x4*)(Ap2 + (size_t)i * 32 * lda);
#pragma unroll
      for (int i = 0; i < NB; ++i) rb[i] = *(const u32x4*)(Bp2 + (size_t)i * 32 * ldb);
    }
    __builtin_amdgcn_sched_barrier(0);
    const unsigned char* Ac = As + cur * ASZ;
    const unsigned char* Bc = Bs + cur * BSZ;
#pragma unroll
    for (int kk = 0; kk < 2; ++kk) {
      bf16x8 af[4], bfv[WN];
#pragma unroll
      for (int mi = 0; mi < 4; ++mi) af[mi] = *(const bf16x8*)(Ac + (wm * 64 + mi * 16 + fr) * RS + kk * 64 + fq * 16);
#pragma unroll
      for (int ni = 0; ni < WN; ++ni) bfv[ni] = *(const bf16x8*)(Bc + (wn * 16 * WN + ni * 16 + fr) * RS + kk * 64 + fq * 16);
#pragma unroll
      for (int mi = 0; mi < 4; ++mi)
#pragma unroll
        for (int ni = 0; ni < WN; ++ni) acc[mi][ni] = __builtin_amdgcn_mfma_f32_16x16x32_bf16(af[mi], bfv[ni], acc[mi][ni], 0, 0, 0);
    }
    {
      unsigned char* An = As + (cur ^ 1) * ASZ;
      unsigned char* Bn = Bs + (cur ^ 1) * BSZ;
#pragma unroll
      for (int i = 0; i < 4; ++i) *(u32x4*)(An + (lr + 32 * i) * RS + lc * 16) = ra[i];
#pragma unroll
      for (int i = 0; i < NB; ++i) *(u32x4*)(Bn + (lr + 32 * i) * RS + lc * 16) = rb[i];
    }
    __syncthreads();
  }
}

template <int WN>
__device__ __forceinline__ void gemm_chain(f32x4 (&acc)[4][WN], const bfu* A, int lda, const bfu* B, int ldb, int K,
                                           unsigned char* smem, bool first, bool has_next, const bfu* nA, int nlda, const bfu* nB, int nldb) {
  constexpr int BN = 32 * WN;
  constexpr int NB = BN / 32;
  constexpr int RS = (WN == 2) ? 160 : 144;
  constexpr int ASZ = 128 * RS, BSZ = BN * RS;
  const int tid = get_tid(), lane = tid & 63, wave = tid >> 6, fr = lane & 15, fq = lane >> 4, wm = wave >> 1, wn = wave & 1;
  unsigned char* As = smem;
  unsigned char* Bs = smem + 2 * ASZ;
  const int lr = tid >> 3, lc = tid & 7;
  u32x4 ra[4], rb[NB];
  const bfu* Ap = A + (size_t)lr * lda + lc * 8;
  const bfu* Bp = B + (size_t)lr * ldb + lc * 8;
  const int nk = K >> 6;
  if (first) {
#pragma unroll
    for (int i = 0; i < 4; ++i) ra[i] = *(const u32x4*)(Ap + (size_t)i * 32 * lda);
#pragma unroll
    for (int i = 0; i < NB; ++i) rb[i] = *(const u32x4*)(Bp + (size_t)i * 32 * ldb);
    __syncthreads();
#pragma unroll
    for (int i = 0; i < 4; ++i) *(u32x4*)(As + (lr + 32 * i) * RS + lc * 16) = ra[i];
#pragma unroll
    for (int i = 0; i < NB; ++i) *(u32x4*)(Bs + (lr + 32 * i) * RS + lc * 16) = rb[i];
    __syncthreads();
  }
  const bfu* nAp = nA + (size_t)lr * nlda + lc * 8;
  const bfu* nBp = nB + (size_t)lr * nldb + lc * 8;
  for (int kt = 0; kt < nk; ++kt) {
    const int cur = kt & 1;
    {
      const bool nx = (kt + 1 >= nk) && has_next;
      const int kn = min(kt + 1, nk - 1);
      const bfu* Ap2 = nx ? nAp : Ap + kn * 64;
      const bfu* Bp2 = nx ? nBp : Bp + kn * 64;
      const size_t sa = (size_t)32 * (nx ? nlda : lda), sb = (size_t)32 * (nx ? nldb : ldb);
#pragma unroll
      for (int i = 0; i < 4; ++i) ra[i] = *(const u32x4*)(Ap2 + i * sa);
#pragma unroll
      for (int i = 0; i < NB; ++i) rb[i] = *(const u32x4*)(Bp2 + i * sb);
    }
    __builtin_amdgcn_sched_barrier(0);
    const unsigned char* Ac = As + cur * ASZ;
    const unsigned char* Bc = Bs + cur * BSZ;
#pragma unroll
    for (int kk = 0; kk < 2; ++kk) {
      bf16x8 af[4], bfv[WN];
#pragma unroll
      for (int mi = 0; mi < 4; ++mi) af[mi] = *(const bf16x8*)(Ac + (wm * 64 + mi * 16 + fr) * RS + kk * 64 + fq * 16);
#pragma unroll
      for (int ni = 0; ni < WN; ++ni) bfv[ni] = *(const bf16x8*)(Bc + (wn * 16 * WN + ni * 16 + fr) * RS + kk * 64 + fq * 16);
#pragma unroll
      for (int mi = 0; mi < 4; ++mi)
#pragma unroll
        for (int ni = 0; ni < WN; ++ni) acc[mi][ni] = __builtin_amdgcn_mfma_f32_16x16x32_bf16(af[mi], bfv[ni], acc[mi][ni], 0, 0, 0);
    }
    {
      unsigned char* An = As + (cur ^ 1) * ASZ;
      unsigned char* Bn = Bs + (cur ^ 1) * BSZ;
#pragma unroll
      for (int i = 0; i < 4; ++i) *(u32x4*)(An + (lr + 32 * i) * RS + lc * 16) = ra[i];
#pragma unroll
      for (int i = 0; i < NB; ++i) *(u32x4*)(Bn + (lr + 32 * i) * RS + lc * 16) = rb[i];
    }
    __syncthreads();
  }
}

__device__ __forceinline__ void gemm_chain8(f32x4 (&acc)[4][2], const bfu* A, int lda, const bfu* B, int ldb, int K,
                                           unsigned char* smem, bool first, bool has_next, const bfu* nA, int nlda, const bfu* nB, int nldb) {
  constexpr int WN = 2;
  constexpr int RS = 160;
  constexpr int ASZ = 128 * RS, BSZ = 128 * RS;
  const int tid = get_tid512(), lane = tid & 63, wave = tid >> 6, fr = lane & 15, fq = lane >> 4, wm = wave >> 2, wn = wave & 3;
  unsigned char* As = smem;
  unsigned char* Bs = smem + 2 * ASZ;
  const int lr = tid >> 3, lc = tid & 7;
  u32x4 ra[2], rb[2];
  const bfu* Ap = A + (size_t)lr * lda + lc * 8;
  const bfu* Bp = B + (size_t)lr * ldb + lc * 8;
  const int nk = K >> 6;
  if (first) {
#pragma unroll
    for (int i = 0; i < 2; ++i) ra[i] = *(const u32x4*)(Ap + (size_t)i * 64 * lda);
#pragma unroll
    for (int i = 0; i < 2; ++i) rb[i] = *(const u32x4*)(Bp + (size_t)i * 64 * ldb);
    __syncthreads();
#pragma unroll
    for (int i = 0; i < 2; ++i) *(u32x4*)(As + (lr + 64 * i) * RS + lc * 16) = ra[i];
#pragma unroll
    for (int i = 0; i < 2; ++i) *(u32x4*)(Bs + (lr + 64 * i) * RS + lc * 16) = rb[i];
    __syncthreads();
  }
  const bfu* nAp = nA + (size_t)lr * nlda + lc * 8;
  const bfu* nBp = nB + (size_t)lr * nldb + lc * 8;
  for (int kt = 0; kt < nk; ++kt) {
    const int cur = kt & 1;
    {
      const bool nx = (kt + 1 >= nk) && has_next;
      const int kn = min(kt + 1, nk - 1);
      const bfu* Ap2 = nx ? nAp : Ap + kn * 64;
      const bfu* Bp2 = nx ? nBp : Bp + kn * 64;
      const size_t sa = (size_t)64 * (nx ? nlda : lda), sb = (size_t)64 * (nx ? nldb : ldb);
#pragma unroll
      for (int i = 0; i < 2; ++i) ra[i] = *(const u32x4*)(Ap2 + i * sa);
#pragma unroll
      for (int i = 0; i < 2; ++i) rb[i] = *(const u32x4*)(Bp2 + i * sb);
    }
    __builtin_amdgcn_sched_barrier(0);
    const unsigned char* Ac = As + cur * ASZ;
    const unsigned char* Bc = Bs + cur * BSZ;
#pragma unroll
    for (int kk = 0; kk < 2; ++kk) {
      bf16x8 af[4], bfv[WN];
#pragma unroll
      for (int mi = 0; mi < 4; ++mi) af[mi] = *(const bf16x8*)(Ac + (wm * 64 + mi * 16 + fr) * RS + kk * 64 + fq * 16);
#pragma unroll
      for (int ni = 0; ni < WN; ++ni) bfv[ni] = *(const bf16x8*)(Bc + (wn * 16 * WN + ni * 16 + fr) * RS + kk * 64 + fq * 16);
#pragma unroll
      for (int mi = 0; mi < 4; ++mi)
#pragma unroll
        for (int ni = 0; ni < WN; ++ni) acc[mi][ni] = __builtin_amdgcn_mfma_f32_16x16x32_bf16(af[mi], bfv[ni], acc[mi][ni], 0, 0, 0);
    }
    {
      unsigned char* An = As + (cur ^ 1) * ASZ;
      unsigned char* Bn = Bs + (cur ^ 1) * BSZ;
#pragma unroll
      for (int i = 0; i < 2; ++i) *(u32x4*)(An + (lr + 64 * i) * RS + lc * 16) = ra[i];
#pragma unroll
      for (int i = 0; i < 2; ++i) *(u32x4*)(Bn + (lr + 64 * i) * RS + lc * 16) = rb[i];
    }
    __syncthreads();
  }
}

template <int WN>
__device__ __forceinline__ void zero_acc(f32x4 (&acc)[4][WN]) {
#pragma unroll
  for (int mi = 0; mi < 4; ++mi)
#pragma unroll
    for (int ni = 0; ni < WN; ++ni) acc[mi][ni] = f32x4{0.f, 0.f, 0.f, 0.f};
}

template <int WN>
__device__ __forceinline__ void acc_to_lds(const f32x4 (&acc)[4][WN], unsigned char* smem) {
  constexpr int LDC = 32 * WN + 4;
  const int tid = get_tid(), lane = tid & 63, wave = tid >> 6, fr = lane & 15, fq = lane >> 4, wm = wave >> 1, wn = wave & 1;
  float* Cs = (float*)smem;
#pragma unroll
  for (int mi = 0; mi < 4; ++mi)
#pragma unroll
    for (int ni = 0; ni < WN; ++ni)
#pragma unroll
      for (int j = 0; j < 4; ++j) Cs[(wm * 64 + mi * 16 + fq * 4 + j) * LDC + wn * 16 * WN + ni * 16 + fr] = acc[mi][ni][j];
  __syncthreads();
}


__device__ __forceinline__ void gemm_big(f32x4 (&acc)[8][4], const bfu* A, int lda, const bfu* B, int ldb, int K, unsigned char* smem) {
  constexpr int ASZ = 256 * 64, STG = 2 * ASZ;
  const int tid = get_tid512(), lane = tid & 63, wave = tid >> 6, fr = lane & 15, fq = lane >> 4, wm = wave >> 2, wn = wave & 3;
  const int nk = K >> 5;
  const int lrow = lane >> 2;
  const int lchunk = (lane & 3) ^ ((lane >> 4) & 2);
  const bfu* Ag = A + (size_t)(wave * 32 + lrow) * lda + lchunk * 8;
  const bfu* Bg = B + (size_t)(wave * 32 + lrow) * ldb + lchunk * 8;
  const int rd_off = fr * 64 + ((fq ^ ((fr >> 2) & 2)) << 4);
  asm volatile("s_waitcnt vmcnt(0)" ::: "memory");
  __syncthreads();
#define GB_ISSUE(kt_, stg_)                                                                                           \
  {                                                                                                                   \
    unsigned char* sb_ = smem + (stg_) * STG;                                                                         \
    _Pragma("unroll") for (int jj = 0; jj < 2; ++jj)                                                                  \
      __builtin_amdgcn_global_load_lds((const unsigned*)(Ag + (size_t)jj * 16 * lda + (kt_) * 32),                    \
                                       (__attribute__((address_space(3))) unsigned*)(sb_ + (wave * 32 + jj * 16) * 64), 16, 0, 0); \
    _Pragma("unroll") for (int jj = 0; jj < 2; ++jj)                                                                  \
      __builtin_amdgcn_global_load_lds((const unsigned*)(Bg + (size_t)jj * 16 * ldb + (kt_) * 32),                    \
                                       (__attribute__((address_space(3))) unsigned*)(sb_ + ASZ + (wave * 32 + jj * 16) * 64), 16, 0, 0); \
  }
  const int grp = __builtin_amdgcn_readfirstlane(wm);
  GB_ISSUE(0, 0);
  if (nk > 1) { GB_ISSUE(1, 1); asm volatile("s_waitcnt vmcnt(4)" ::: "memory"); }
  else asm volatile("s_waitcnt vmcnt(0)" ::: "memory");
  if (grp == 1) __builtin_amdgcn_s_barrier();
  __builtin_amdgcn_s_barrier();
  int stg = 0;
  for (int kt = 0; kt < nk; ++kt) {
    if (kt + 2 < nk) {
      const int s2 = (stg >= 1) ? stg - 1 : 2;
      GB_ISSUE(kt + 2, s2);
    }
    const unsigned char* Ac = smem + stg * STG + rd_off;
    const unsigned char* Bc = Ac + ASZ;
    bf16x8 bfv[4], af[8];
#pragma unroll
    for (int ni = 0; ni < 4; ++ni) bfv[ni] = *(const bf16x8*)(Bc + (wn * 64 + ni * 16) * 64);
#pragma unroll
    for (int mi = 0; mi < 8; ++mi) af[mi] = *(const bf16x8*)(Ac + (wm * 128 + mi * 16) * 64);
    if (kt + 2 < nk) asm volatile("s_waitcnt vmcnt(4)" ::: "memory");
    else asm volatile("s_waitcnt vmcnt(0)" ::: "memory");
    asm volatile("s_waitcnt lgkmcnt(0)" ::: "memory");
    __builtin_amdgcn_sched_barrier(0);
    __builtin_amdgcn_s_barrier();
    __builtin_amdgcn_sched_barrier(0);
    __builtin_amdgcn_s_setprio(1);
#pragma unroll
    for (int mi = 0; mi < 8; ++mi)
#pragma unroll
      for (int ni = 0; ni < 4; ++ni)
        acc[mi][ni] = __builtin_amdgcn_mfma_f32_16x16x32_bf16(af[mi], bfv[ni], acc[mi][ni], 0, 0, 0);
    __builtin_amdgcn_s_setprio(0);
    __builtin_amdgcn_sched_barrier(0);
    __builtin_amdgcn_s_barrier();
    __builtin_amdgcn_sched_barrier(0);
    stg = (stg == 2) ? 0 : stg + 1;
  }
  if (grp == 0) __builtin_amdgcn_s_barrier();
#undef GB_ISSUE
}
__device__ __forceinline__ void zero_acc_big(f32x4 (&acc)[8][4]) {
#pragma unroll
  for (int mi = 0; mi < 8; ++mi)
#pragma unroll
    for (int ni = 0; ni < 4; ++ni) acc[mi][ni] = f32x4{0.f, 0.f, 0.f, 0.f};
}
__device__ __forceinline__ void acc_to_lds_big(const f32x4 (&acc)[8][4], int ch, unsigned char* smem) {
  const int tid = get_tid512(), lane = tid & 63, wave = tid >> 6, fr = lane & 15, fq = lane >> 4, wm = wave >> 2, wn = wave & 3;
  float* Cs = (float*)smem;
  __syncthreads();
  if ((wn >> 1) == ch) {
#pragma unroll
    for (int mi = 0; mi < 8; ++mi)
#pragma unroll
      for (int ni = 0; ni < 4; ++ni)
#pragma unroll
        for (int j = 0; j < 4; ++j) Cs[(wm * 128 + mi * 16 + fq * 4 + j) * 132 + (wn & 1) * 64 + ni * 16 + fr] = acc[mi][ni][j];
  }
  __syncthreads();
}

__device__ __forceinline__ void tile_mn(int id, int Mt, int Nt, int& mt, int& nt) {
  const int per = 8 * Nt;
  const int grp = id / per, within = id - grp * per;
  const int gsz = min(8, Mt - grp * 8);
  mt = grp * 8 + within % gsz;
  nt = within / gsz;
}
#define FOR_TILES(id, n)                                                              \
  for (int _q = blockIdx.x >> 3; ((_q >> 6) << 9) < (n); _q += (gridDim.x >> 3))       \
    for (int id = ((_q >> 6) << 9) + ((blockIdx.x & 7) << 6) + (_q & 63), _once = 1; _once && id < (n); _once = 0)
#define FOR_TILES_V(id, n)                                                                            \
  for (int _q = ((blockIdx.x >> 3) << 1) + vb_id(); ((_q >> 6) << 9) < (n); _q += ((gridDim.x >> 3) << 1)) \
    for (int id = ((_q >> 6) << 9) + ((blockIdx.x & 7) << 6) + (_q & 63), _once = 1; _once && id < (n); _once = 0)

struct CD { const float* src; bfu* dst; const float* ks; int sld, c0, K, Nv, Np, mode; };

__device__ __forceinline__ void get_cd(const Params& p, int l, int idx, CD& d) {
  unsigned char* ws = p.ws;
  d.ks = nullptr; d.c0 = 0; d.mode = 0;
  switch (idx) {
    case 0: case 1:
      d.src = p.in[idx == 0 ? 5 : 6] + (size_t)l * 1024 * 2816; d.sld = 2816; d.K = 1024; d.Nv = 2816; d.Np = 2816; d.mode = idx + 1; d.dst = (bfu*)(ws + OFF_WGU1); break;
    case 2:
      d.src = p.in[7] + (size_t)l * 2816 * 1024; d.sld = 1024; d.K = 2816; d.Nv = 1024; d.Np = 1024; d.dst = (bfu*)(ws + OFF_WD1); break;
    case 3: case 4:
      d.src = p.in[idx == 3 ? 31 : 32] + (size_t)l * 1024 * 2816; d.sld = 2816; d.K = 1024; d.Nv = 2816; d.Np = 2816; d.mode = idx - 2; d.dst = (bfu*)(ws + OFF_WGU2); break;
    case 5:
      d.src = p.in[33] + (size_t)l * 2816 * 1024; d.sld = 1024; d.K = 2816; d.Nv = 1024; d.Np = 1024; d.dst = (bfu*)(ws + OFF_WD2); break;
    case 6:
      d.src = p.in[9] + (size_t)l * 1024 * 7264; d.sld = 7264; d.K = 1024; d.Nv = 2144; d.Np = 2304; d.dst = (bfu*)(ws + OFF_WINA); break;
    case 7:
      d.src = p.in[9] + (size_t)l * 1024 * 7264; d.sld = 7264; d.c0 = 2144; d.K = 1024; d.Nv = 5120; d.Np = 5120; d.dst = (bfu*)(ws + OFF_WING); break;
    case 8: case 9: case 10: case 11: case 12:
      d.src = p.in[28] + (size_t)(l * 5 + (idx - 8)) * 256 * 1024; d.sld = 1024; d.K = 256; d.Nv = 1024; d.Np = 1024; d.dst = (bfu*)(ws + OFF_WBR) + (size_t)(idx - 8) * 1024 * 256; break;
    case 13:
      d.src = p.in[29] + (size_t)l * 1024 * 1024; d.sld = 1024; d.K = 1024; d.Nv = 1024; d.Np = 1024; d.dst = (bfu*)(ws + OFF_WOUT); break;
    case 14:
      d.src = p.in[27] + (size_t)l * 1024 * 512; d.sld = 512; d.K = 1024; d.Nv = 512; d.Np = 512; d.dst = (bfu*)(ws + OFF_WMEM); break;
    case 15:
      d.src = p.in[18] + (size_t)l * 65536; d.sld = 256; d.K = 256; d.Nv = 256; d.Np = 256; d.dst = (bfu*)(ws + OFF_WGLU); break;
    case 16:
      d.src = p.in[23] + (size_t)l * 192 * 384; d.sld = 384; d.K = 192; d.Nv = 384; d.Np = 384; d.ks = p.in[22] + l * 192; d.dst = (bfu*)(ws + OFF_WQUP); break;
    default:
      d.src = p.in[25] + (size_t)l * 128 * 512; d.sld = 512; d.K = 128; d.Nv = 512; d.Np = 512; d.ks = p.in[24] + l * 128; d.dst = (bfu*)(ws + OFF_WKVUP); break;
  }
}
constexpr int NCD = 18;
__device__ __forceinline__ int cd_tiles(int idx) {
  switch (idx) {
    case 0: case 1: case 3: case 4: return 16 * 44;
    case 2: case 5: return 44 * 16;
    case 6: return 16 * 36;
    case 7: return 16 * 80;
    case 8: case 9: case 10: case 11: case 12: return 4 * 16;
    case 13: return 16 * 16;
    case 14: return 16 * 8;
    case 15: return 4 * 4;
    case 16: return 3 * 6;
    default: return 2 * 8;
  }
}

__device__ __forceinline__ void conv_tile(const CD& d, int tile, unsigned char* smem) {
  float* sm = (float*)smem;
  const int tid = get_tid();
  const int tn = d.Np >> 6;
  const int tk = tile / tn, tnn = tile - tk * tn;
  const int k0 = tk * 64, n0 = tnn * 64;
  __syncthreads();
  {
    const int n = n0 + (tid & 63);
    const bool ok = n < d.Nv;
    float v[16];
#pragma unroll
    for (int i = 0; i < 16; ++i) {
      const int kr = (tid >> 6) + i * 4;
      v[i] = ok ? d.src[(size_t)(k0 + kr) * d.sld + d.c0 + n] : 0.f;
    }
    if (d.ks) {
#pragma unroll
      for (int i = 0; i < 16; ++i) v[i] *= d.ks[k0 + (tid >> 6) + i * 4];
    }
#pragma unroll
    for (int i = 0; i < 16; ++i) sm[((tid >> 6) + i * 4) * 65 + (tid & 63)] = v[i];
  }
  __syncthreads();
#pragma unroll
  for (int i = 0; i < 8; ++i) {
    const int n = (tid >> 5) + i * 8;
    const int kk = (tid & 31) * 2;
    const float v0 = sm[kk * 65 + n], v1 = sm[(kk + 1) * 65 + n];
    int drow = n0 + n;
    if (d.mode != 0) {
      const int g = drow >> 7, hc = drow & 127;
      drow = g * 256 + (hc >> 5) * 64 + ((hc >> 4) & 1) * 32 + (d.mode == 2 ? 16 : 0) + (hc & 15);
    }
    *(unsigned*)(d.dst + (size_t)drow * d.K + k0 + kk) = pack2(v0, v1);
  }
}

__device__ __forceinline__ void rms_row(const float* x, const float* g, bfu* outb, float* copy_f, float* norm_f) {
  const int lane = get_tid() & 63;
  float4 v[4];
  float ss = 0.f;
#pragma unroll
  for (int i = 0; i < 4; ++i) {
    v[i] = *(const float4*)(x + (i * 64 + lane) * 4);
    ss += v[i].x * v[i].x + v[i].y * v[i].y + v[i].z * v[i].z + v[i].w * v[i].w;
  }
  ss = wave_sum(ss);
  const float r = rsqrtf(ss * (1.f / 1024.f) + 1e-6f);
#pragma unroll
  for (int i = 0; i < 4; ++i) {
    const int idx = (i * 64 + lane) * 4;
    const float4 gg = *(const float4*)(g + idx);
    float4 y;
    y.x = v[i].x * r * gg.x; y.y = v[i].y * r * gg.y; y.z = v[i].z * r * gg.z; y.w = v[i].w * r * gg.w;
    if (outb) { u32x2 o; o.x = pack2(y.x, y.y); o.y = pack2(y.z, y.w); *(u32x2*)(outb + idx) = o; }
    if (copy_f) *(float4*)(copy_f + idx) = v[i];
    if (norm_f) *(float4*)(norm_f + idx) = y;
  }
}

__device__ __forceinline__ void norm_rows_phase(const Params& p, const float* gain, int first_layer_copy, int w) {
  const int row = w * 4 + (get_tid() >> 6);
  bfu* xn = (bfu*)(p.ws + OFF_XN) + (size_t)row * 1024;
  if (first_layer_copy) {
    const float* x = (row < 16384) ? (p.in[0] + (size_t)row * 1024) : (p.in[1] + (size_t)(row - 16384) * 1024);
    rms_row(x, gain, xn, p.out + (size_t)row * 1024, nullptr);
  } else {
    rms_row(p.out + (size_t)row * 1024, gain, xn, nullptr, nullptr);
  }
}

__device__ __forceinline__ int t5_bucket(int rel) {
  const int nb = 16, max_exact = 8;
  int ret = (rel > 0) ? nb : 0;
  int n = rel < 0 ? -rel : rel;
  if (n < max_exact) return ret + n;
  int large = max_exact + (int)(log((double)n / 8.0) / log(16.0) * 8.0 + 1e-9);
  if (large > nb - 1) large = nb - 1;
  return ret + large;
}

__device__ __forceinline__ void phase_prep(const Params& p, int l, unsigned char* smem) {
  int nconv = 0;
#pragma unroll 1
  for (int i = 0; i < NCD; ++i) nconv += cd_tiles(i);
  for (int w = VBLK; w < nconv; w += VGRID) {
    int x = w;
    int i = 0;
    while (x >= cd_tiles(i)) { x -= cd_tiles(i); ++i; }
    CD d; get_cd(p, l, i, d);
    conv_tile(d, x, smem);
  }
  const int n_norm = T / 4, n_mem = 1536 / 4;
  for (int w = VBLK; w < n_norm + n_mem; w += VGRID) {
    if (w < n_norm) { norm_rows_phase(p, p.in[4] + l * 1024, l == 0, w); }
    else {
      const int row = (w - n_norm) * 4 + (get_tid() >> 6);
      const float* src = (row < 512) ? (p.in[2] + (size_t)row * 1024) : (p.in[3] + (size_t)(row - 512) * 1024);
      rms_row(src, p.in[26] + l * 1024, (bfu*)(p.ws + OFF_MEMN) + (size_t)row * 1024, nullptr, nullptr);
    }
  }
  const int n_ssm = 8;
  const int n_misc = (l == 0) ? (512 + 5) : 0;
  for (int w = VBLK; w < 256; w += VGRID) {
    const int q = w * 256 + get_tid();
    const int e = q >> 5, ee = q & 31;
    const int d = e >> 10, g = (e >> 6) & 15, nn = e & 63;
    const int li_ = (l * 2 + d) * 16 + g;
    const double lr = p.in[10][(size_t)li_ * 64 + nn], li = p.in[11][(size_t)li_ * 64 + nn];
    const double dt = exp((double)p.in[12][li_]);
    const double mag = exp(lr * dt);
    const double are = mag * cos(li * dt), aim = mag * sin(li * dt);
    const double den = lr * lr + li * li;
    const double xr = are - 1.0;
    const double kre = (xr * lr + aim * li) / den, kim = (aim * lr - xr * li) / den;
    const double magp = exp(lr * dt * ee);
    const double pr = magp * cos(li * dt * ee), pi = magp * sin(li * dt * ee);
    const int t = d ? ee : 31 - ee;
    const float* bre = p.in[13] + ((size_t)li_ * 64 + nn) * 16;
    const float* bim = p.in[14] + ((size_t)li_ * 64 + nn) * 16;
    bfu* WE = (bfu*)(p.ws + OFF_WEND);
    unsigned wr[8], wi[8];
#pragma unroll
    for (int pp = 0; pp < 16; pp += 2) {
      const double br0 = bre[pp], bi0 = bim[pp], br1 = bre[pp + 1], bi1 = bim[pp + 1];
      const double vre0 = kre * br0 - kim * bi0, vim0 = kre * bi0 + kim * br0;
      const double vre1 = kre * br1 - kim * bi1, vim1 = kre * bi1 + kim * br1;
      wr[pp >> 1] = pack2((float)(pr * vre0 - pi * vim0), (float)(pr * vre1 - pi * vim1));
      wi[pp >> 1] = pack2((float)(pr * vim0 + pi * vre0), (float)(pr * vim1 + pi * vre1));
    }
    u32x4* dre = (u32x4*)(WE + ((size_t)((d * 16 + g) * 128 + nn)) * 512 + t * 16);
    u32x4* dim = (u32x4*)(WE + ((size_t)((d * 16 + g) * 128 + 64 + nn)) * 512 + t * 16);
    dre[0] = u32x4{wr[0], wr[1], wr[2], wr[3]}; dre[1] = u32x4{wr[4], wr[5], wr[6], wr[7]};
    dim[0] = u32x4{wi[0], wi[1], wi[2], wi[3]}; dim[1] = u32x4{wi[4], wi[5], wi[6], wi[7]};
  }
  for (int w = VGRID - 1 - VBLK; w < n_ssm + n_misc; w += VGRID) {
    int x = w;
    if (x < n_ssm) {
      const int e = x * 256 + get_tid();
      const int d = e >> 10, g = (e >> 6) & 15;
      const int li_ = (l * 2 + d) * 16 + g;
      const double lr = p.in[10][(size_t)li_ * 64 + (e & 63)], li = p.in[11][(size_t)li_ * 64 + (e & 63)];
      const double dt = exp((double)p.in[12][li_]);
      const double mag = exp(lr * dt);
      const double are = mag * cos(li * dt), aim = mag * sin(li * dt);
      const double den = lr * lr + li * li;
      const double xr = are - 1.0;
      const double kre = (xr * lr + aim * li) / den, kim = (aim * lr - xr * li) / den;
      float2* SA = (float2*)(p.ws + OFF_SA);
      float2* SAP = (float2*)(p.ws + OFF_SAP);
      float2* SBB = (float2*)(p.ws + OFF_SBB);
      SA[e] = make_float2((float)are, (float)aim);
      const double magp = exp(lr * dt * 32.0);
      SAP[e] = make_float2((float)(magp * cos(li * dt * 32.0)), (float)(magp * sin(li * dt * 32.0)));
      const float* bre = p.in[13] + ((size_t)li_ * 64 + (e & 63)) * 16;
      const float* bim = p.in[14] + ((size_t)li_ * 64 + (e & 63)) * 16;
      bfu* BBH = (bfu*)(p.ws + OFF_BBH);
      bfu* CCH = (bfu*)(p.ws + OFF_CCH);
      const int nn = e & 63;
#pragma unroll 1
      for (int pp = 0; pp < 16; ++pp) {
        const double br = bre[pp], bi = bim[pp];
        const float vre = (float)(kre * br - kim * bi), vim = (float)(kre * bi + kim * br);
        SBB[(size_t)e * 16 + pp] = make_float2(vre, vim);
        BBH[((size_t)((d * 16 + g) * 128 + nn)) * 16 + pp] = f2bf(vre);
        BBH[((size_t)((d * 16 + g) * 128 + 64 + nn)) * 16 + pp] = f2bf(vim);
        const size_t cidx = ((size_t)(li_ * 16 + pp)) * 64 + nn;
        CCH[((size_t)((d * 16 + g) * 16 + pp)) * 128 + nn] = f2bf(p.in[15][cidx]);
        CCH[((size_t)((d * 16 + g) * 16 + pp)) * 128 + 64 + nn] = f2bf(-p.in[16][cidx]);
      }
      continue;
    }
    x -= n_ssm;
    if (x < 512) {
      const int e = x * 256 + get_tid();
      const int pos = e >> 4, i = e & 15;
      const double inv = pow(10000.0, -(double)i / 16.0);
      const double ang = (double)pos * inv;
      float* rc = (float*)(p.ws + OFF_ROPE);
      rc[e] = (float)cos(ang);
      rc[8192 * 16 + e] = (float)sin(ang);
      continue;
    }
    x -= 512;
    {
      const int e = x * 256 + get_tid();
      if (e < 4 * 257) {
        const int h = e / 257, r = e - h * 257;
        float* t5 = (float*)(p.ws + OFF_T5);
        t5[e] = p.in[20][t5_bucket(r - 128) * 4 + h] * LOG2E;
      }
    }
  }
}

__device__ __forceinline__ void phase_ffn_gu(const Params& p, int which, unsigned char* smem) {
  const bfu* XN = (const bfu*)(p.ws + OFF_XN);
  const bfu* W = (const bfu*)(p.ws + (which ? OFF_WGU2 : OFF_WGU1));
  bfu* HID = (bfu*)(p.ws + OFF_RA);
  const int Mt = T / 256, Nt = 22;
  FOR_TILES(id, Mt * Nt) {
    int mt, nt; tile_mn(id, Mt, Nt, mt, nt);
    f32x4 acc[8][4]; zero_acc_big(acc);
    gemm_big(acc, XN + (size_t)mt * 256 * 1024, 1024, W + (size_t)nt * 256 * 1024, 1024, 1024, smem);
    const int tid = get_tid512(), lane = tid & 63, wave = tid >> 6, fr = lane & 15, fq = lane >> 4, wm = wave >> 2, wn = wave & 3;
    bfu* Hs = (bfu*)smem;
    __syncthreads();
#pragma unroll
    for (int mi = 0; mi < 8; ++mi)
#pragma unroll
      for (int q = 0; q < 2; ++q)
#pragma unroll
        for (int j = 0; j < 4; ++j) {
          const float g = acc[mi][2 * q][j], u = acc[mi][2 * q + 1][j];
          Hs[(wm * 128 + mi * 16 + fq * 4 + j) * 136 + wn * 32 + q * 16 + fr] = f2bf(g * sigmoidf_(g) * u);
        }
    __syncthreads();
#pragma unroll
    for (int it = 0; it < 8; ++it) {
      const int cid = it * 512 + tid;
      const int r = cid >> 4, c = (cid & 15) * 8;
      *(u32x4*)(HID + (size_t)(mt * 256 + r) * 2816 + nt * 128 + c) = *(const u32x4*)(Hs + r * 136 + c);
    }
  }
}

__device__ __forceinline__ void phase_resid_gemm(const Params& p, const bfu* A, int lda, int K, const bfu* W, float alpha, unsigned char* smem) {
  const int Mt = T / 256, Nt = 4;
  FOR_TILES(id, Mt * Nt) {
    int mt, nt; tile_mn(id, Mt, Nt, mt, nt);
    f32x4 acc[8][4]; zero_acc_big(acc);
    gemm_big(acc, A + (size_t)mt * 256 * lda, lda, W + (size_t)nt * 256 * K, K, K, smem);
    const float* Cs = (const float*)smem;
#pragma unroll 1
    for (int ch = 0; ch < 2; ++ch) {
      acc_to_lds_big(acc, ch, smem);
#pragma unroll
      for (int it = 0; it < 8; ++it) {
        const int cid = it * 512 + get_tid512();
        const int r = cid >> 4, c = (cid & 15) * 8;
        float* hp = p.out + (size_t)(mt * 256 + r) * 1024 + nt * 256 + ch * 128 + c;
        float4 h0 = *(float4*)hp, h1 = *(float4*)(hp + 4);
        const float* cs = Cs + r * 132 + c;
        h0.x += alpha * cs[0]; h0.y += alpha * cs[1]; h0.z += alpha * cs[2]; h0.w += alpha * cs[3];
        h1.x += alpha * cs[4]; h1.y += alpha * cs[5]; h1.z += alpha * cs[6]; h1.w += alpha * cs[7];
        *(float4*)hp = h0; *(float4*)(hp + 4) = h1;
      }
    }
  }
}

__device__ __forceinline__ void plain_tile(const bfu* A, int lda, const bfu* W, int K, bfu* out, int ldo, unsigned char* smem) {
  f32x4 acc[4][4]; zero_acc<4>(acc);
  gemm_main<4>(acc, A, lda, W, K, K, smem);
  acc_to_lds<4>(acc, smem);
  const float* Cs = (const float*)smem;
#pragma unroll
  for (int it = 0; it < 8; ++it) {
    const int cid = it * 256 + get_tid();
    const int r = cid >> 4, c = (cid & 15) * 8;
    const float* cs = Cs + r * 132 + c;
    u32x4 st; st.x = pack2(cs[0], cs[1]); st.y = pack2(cs[2], cs[3]); st.z = pack2(cs[4], cs[5]); st.w = pack2(cs[6], cs[7]);
    *(u32x4*)(out + (size_t)r * ldo + c) = st;
  }
}

__device__ __forceinline__ void plain_big(const bfu* A, int lda, const bfu* W, int K, bfu* out, int ldo, int ncols, unsigned char* smem) {
  f32x4 acc[8][4]; zero_acc_big(acc);
  gemm_big(acc, A, lda, W, K, K, smem);
  const float* Cs = (const float*)smem;
#pragma unroll 1
  for (int ch = 0; ch < 2; ++ch) {
    acc_to_lds_big(acc, ch, smem);
    if (ch * 128 < ncols) {
#pragma unroll
      for (int it = 0; it < 8; ++it) {
        const int cid = it * 512 + get_tid512();
        const int r = cid >> 4, c = (cid & 15) * 8;
        const float* cs = Cs + r * 132 + c;
        u32x4 st; st.x = pack2(cs[0], cs[1]); st.y = pack2(cs[2], cs[3]); st.z = pack2(cs[4], cs[5]); st.w = pack2(cs[6], cs[7]);
        *(u32x4*)(out + (size_t)r * ldo + ch * 128 + c) = st;
      }
    }
  }
}

__device__ __forceinline__ void phase_inproj(const Params& p, unsigned char* smem) {
  const bfu* XN = (const bfu*)(p.ws + OFF_XN);
  bfu* RA = (bfu*)(p.ws + OFF_RA);
  const int Mt = T / 256, Nt = 9;
  const int n1 = Mt * Nt, n2 = 6 * 2;
  FOR_TILES(id, n1 + n2) {
    if (id < n1) {
      int mt, nt; tile_mn(id, Mt, Nt, mt, nt);
      plain_big(XN + (size_t)mt * 256 * 1024, 1024, (const bfu*)(p.ws + OFF_WINA) + (size_t)nt * 256 * 1024, 1024,
                RA + (size_t)mt * 256 * 2176 + nt * 256, 2176, 2176 - nt * 256, smem);
    } else {
      const int x = id - n1; const int mt = x >> 1, nt = x & 1;
      plain_big((const bfu*)(p.ws + OFF_MEMN) + (size_t)mt * 256 * 1024, 1024, (const bfu*)(p.ws + OFF_WMEM) + (size_t)nt * 256 * 1024, 1024,
                (bfu*)(p.ws + OFF_MEMKV) + (size_t)mt * 256 * 512 + nt * 256, 512, 256, smem);
    }
  }
}

template <bool FULL>
__device__ __forceinline__ void s5_item(const Params& p, int l, int ci, unsigned char* smem) {
  const int tid = get_tid(), lane = tid & 63, wave = tid >> 6, fr = lane & 15, fq = lane >> 4;
  bfu* ub = (bfu*)smem;
  float* BU = (float*)(smem + 16384) + wave * (16 * 128);
  bfu* SB = (bfu*)(smem + 16384 + 32768) + wave * (16 * 136);
  bfu* RA = (bfu*)(p.ws + OFF_RA);
  const bfu* src = RA + (size_t)ci * 32 * 2176;
  __syncthreads();
#pragma unroll
  for (int i = 0; i < 4; ++i) {
    const int id = tid + 256 * i; const int r = id >> 5, c = id & 31;
    *(u32x4*)(ub + r * 256 + c * 8) = *(const u32x4*)(src + (size_t)r * 2176 + c * 8);
  }
  __syncthreads();
  const float2* SA = (const float2*)(p.ws + OFF_SA);
  float2* E = (float2*)(p.ws + OFF_S5E);
  const bfu* BBH = (const bfu*)(p.ws + OFF_BBH);
  const bfu* CCH = (const bfu*)(p.ws + OFF_CCH);
  const bf16x8 zero8 = {0, 0, 0, 0, 0, 0, 0, 0};
  const float* dsk = p.in[17] + l * 256;
#pragma unroll 1
  for (int gi = 0; gi < 4; ++gi) {
    const int g = wave * 4 + gi;
    f32x4 yacc[2];
    yacc[0] = f32x4{0.f, 0.f, 0.f, 0.f}; yacc[1] = f32x4{0.f, 0.f, 0.f, 0.f};
#pragma unroll 1
    for (int d = 0; d < 2; ++d) {
      const int e = d * 1024 + g * 64 + lane;
      const float2 a = SA[e];
      float xr = 0.f, xi = 0.f;
      if (FULL) { const float2 x0 = E[(size_t)ci * 2048 + e]; xr = x0.x; xi = x0.y; }
      bf16x8 bbf[8];
#pragma unroll
      for (int nt = 0; nt < 8; ++nt)
        bbf[nt] = (fq < 2) ? *(const bf16x8*)(BBH + ((size_t)((d * 16 + g) * 128 + nt * 16 + fr)) * 16 + fq * 8) : zero8;
      bf16x8 ccf[4];
      if (FULL) {
#pragma unroll
        for (int kk = 0; kk < 4; ++kk) ccf[kk] = *(const bf16x8*)(CCH + ((size_t)((d * 16 + g) * 16 + fr)) * 128 + kk * 32 + fq * 8);
      }
#pragma unroll
      for (int s2 = 0; s2 < 2; ++s2) {
        const int sc = d ? 1 - s2 : s2;
        const bf16x8 af = (fq < 2) ? *(const bf16x8*)(ub + (sc * 16 + fr) * 256 + g * 16 + fq * 8) : zero8;
        f32x4 rr[8];
#pragma unroll
        for (int nt = 0; nt < 8; ++nt) rr[nt] = __builtin_amdgcn_mfma_f32_16x16x32_bf16(af, bbf[nt], f32x4{0.f, 0.f, 0.f, 0.f}, 0, 0, 0);
        __builtin_amdgcn_sched_barrier(0);
        asm volatile("s_nop 15\n\ts_nop 15\n\ts_nop 15" ::: "memory");
        __builtin_amdgcn_sched_barrier(0);
#pragma unroll
        for (int nt = 0; nt < 8; ++nt)
#pragma unroll
          for (int j = 0; j < 4; ++j) BU[(fq * 4 + j) * 128 + nt * 16 + fr] = rr[nt][j];
        asm volatile("s_waitcnt lgkmcnt(0)" ::: "memory");
#pragma unroll 4
        for (int st = 0; st < 16; ++st) {
          const int tt = d ? 15 - st : st;
          const float br = BU[tt * 128 + lane], bi = BU[tt * 128 + 64 + lane];
          const float nx = a.x * xr - a.y * xi + br, ny = a.x * xi + a.y * xr + bi;
          xr = nx; xi = ny;
          if (FULL) { SB[tt * 136 + lane] = f2bf(nx); SB[tt * 136 + 64 + lane] = f2bf(ny); }
        }
        asm volatile("s_waitcnt lgkmcnt(0)" ::: "memory");
        if (FULL) {
          f32x4 r = yacc[sc];
#pragma unroll
          for (int kk = 0; kk < 4; ++kk) {
            const bf16x8 sa = *(const bf16x8*)(SB + fr * 136 + kk * 32 + fq * 8);
            r = __builtin_amdgcn_mfma_f32_16x16x32_bf16(sa, ccf[kk], r, 0, 0, 0);
          }
          yacc[sc] = r;
          asm volatile("s_waitcnt lgkmcnt(0)" ::: "memory");
        }
      }
      if (!FULL) E[(size_t)ci * 2048 + e] = make_float2(xr, xi);
    }
    if (FULL) {
#pragma unroll
      for (int sc = 0; sc < 2; ++sc)
#pragma unroll
        for (int j = 0; j < 4; ++j) {
          const int t = sc * 16 + fq * 4 + j, col = g * 16 + fr;
          const float v = yacc[sc][j] + dsk[col] * bf2f(ub[t * 256 + col]);
          RA[(size_t)(ci * 32 + t) * 2176 + col] = f2bf(geluf_(v));
        }
    }
  }
}

__device__ __forceinline__ void s5a_item(const Params& p, int l, int ci, unsigned char* smem) {
  const int tid = get_tid(), lane = tid & 63, wave = tid >> 6;
  bfu* ub = (bfu*)smem;
  const bfu* src = (const bfu*)(p.ws + OFF_RA) + (size_t)ci * 32 * 2176;
  __syncthreads();
#pragma unroll
  for (int i = 0; i < 4; ++i) {
    const int id = tid + 256 * i; const int r = id >> 5, c = id & 31;
    *(u32x4*)(ub + r * 256 + c * 8) = *(const u32x4*)(src + (size_t)r * 2176 + c * 8);
  }
  __syncthreads();
  const float2* SA = (const float2*)(p.ws + OFF_SA);
  const float2* SBB = (const float2*)(p.ws + OFF_SBB);
  float2* E = (float2*)(p.ws + OFF_S5E);
  for (int gi = 0; gi < 4; ++gi) {
    const int g = wave * 4 + gi;
    for (int d = 0; d < 2; ++d) {
      const int e = d * 1024 + g * 64 + lane;
      const float2 a = SA[e];
      float bbr[16], bbi[16];
#pragma unroll
      for (int q = 0; q < 8; ++q) { const f32x4 t4 = *(const f32x4*)(SBB + (size_t)e * 16 + q * 2); bbr[2 * q] = t4[0]; bbi[2 * q] = t4[1]; bbr[2 * q + 1] = t4[2]; bbi[2 * q + 1] = t4[3]; }
      float xr = 0.f, xi = 0.f;
      for (int s = 0; s < 32; ++s) {
        const int t = d ? 31 - s : s;
        const u32x4 u0 = *(const u32x4*)(ub + t * 256 + g * 16), u1 = *(const u32x4*)(ub + t * 256 + g * 16 + 8);
        float uu[16]; unpack8(u0, uu); unpack8(u1, uu + 8);
        float br = 0.f, bi = 0.f;
#pragma unroll
        for (int q = 0; q < 16; ++q) { br += bbr[q] * uu[q]; bi += bbi[q] * uu[q]; }
        const float nx = a.x * xr - a.y * xi + br, ny = a.x * xi + a.y * xr + bi;
        xr = nx; xi = ny;
      }
      E[(size_t)ci * 2048 + e] = make_float2(xr, xi);
    }
  }
}

__device__ __forceinline__ void s5a_gemm_item(const Params& p, int x, unsigned char* smem) {
  const int tid = get_tid();
  const int mtile = x & 7, gd = x >> 3, g = gd >> 1, d = gd & 1;
  const bfu* A = (const bfu*)(p.ws + OFF_RA) + (size_t)(mtile * 128) * 32 * 2176 + g * 16;
  const bfu* B = (const bfu*)(p.ws + OFF_WEND) + (size_t)((d * 16 + g) * 128) * 512;
  f32x4 acc[4][4]; zero_acc<4>(acc);
  gemm_s5a(acc, A, B, 512, smem);
  acc_to_lds<4>(acc, smem);
  const float* Cs = (const float*)smem;
  float2* E = (float2*)(p.ws + OFF_S5E);
#pragma unroll 4
  for (int it = 0; it < 32; ++it) {
    const int cid = it * 256 + tid;
    const int m = cid >> 6, n = cid & 63;
    E[(size_t)(mtile * 128 + m) * 2048 + d * 1024 + g * 64 + n] = make_float2(Cs[m * 132 + n], Cs[m * 132 + 64 + n]);
  }
}

__device__ __forceinline__ void s5b_item(const Params& p, int w) {
  const int gid = w * 256 + get_tid();
  const int seq = gid >> 11, e = gid & 2047, d = e >> 10;
  int start, len;
  if (seq < 2) { start = seq * 8192; len = 8192; } else { start = 16384 + (seq - 2) * 4096; len = 4096; }
  const int c0 = start >> 5, nc = len >> 5;
  const float2 ap = ((const float2*)(p.ws + OFF_SAP))[e];
  float2* E = (float2*)(p.ws + OFF_S5E);
  float cr = 0.f, cim = 0.f;
  for (int b = 0; b < nc; b += 16) {
    float tr[16], ti[16];
#pragma unroll
    for (int i = 0; i < 16; ++i) { const int c = d ? (nc - 1 - (b + i)) : (b + i); const float2 tt = E[(size_t)(c0 + c) * 2048 + e]; tr[i] = tt.x; ti[i] = tt.y; }
#pragma unroll
    for (int i = 0; i < 16; ++i) {
      const int c = d ? (nc - 1 - (b + i)) : (b + i);
      E[(size_t)(c0 + c) * 2048 + e] = make_float2(cr, cim);
      const float nr = ap.x * cr - ap.y * cim + tr[i], ni = ap.x * cim + ap.y * cr + ti[i];
      cr = nr; cim = ni;
    }
  }
}

__device__ __forceinline__ void s5c_item(const Params& p, int l, int ci, unsigned char* smem) {
  const int tid = get_tid(), lane = tid & 63, wave = tid >> 6;
  bfu* ub = (bfu*)smem;
  float* y = (float*)(smem + 16384);
  float* sre = (float*)(smem + 49152) + wave * (2 * 8 * 68);
  float* sim = sre + 8 * 68;
  bfu* RA = (bfu*)(p.ws + OFF_RA);
  const bfu* src = RA + (size_t)ci * 32 * 2176;
  __syncthreads();
#pragma unroll
  for (int i = 0; i < 4; ++i) {
    const int id = tid + 256 * i; const int r = id >> 5, c = id & 31;
    *(u32x4*)(ub + r * 256 + c * 8) = *(const u32x4*)(src + (size_t)r * 2176 + c * 8);
  }
#pragma unroll
  for (int i = 0; i < 32; ++i) y[tid + 256 * i] = 0.f;
  __syncthreads();
  const float2* SA = (const float2*)(p.ws + OFF_SA);
  const float2* SBB = (const float2*)(p.ws + OFF_SBB);
  const float2* E = (const float2*)(p.ws + OFF_S5E);
  const int tsub = lane >> 4, pp = lane & 15;
  for (int gi = 0; gi < 4; ++gi) {
    const int g = wave * 4 + gi;
    for (int d = 0; d < 2; ++d) {
      const int e = d * 1024 + g * 64 + lane;
      const float2 a = SA[e];
      float bbr[16], bbi[16];
#pragma unroll
      for (int q = 0; q < 8; ++q) { const f32x4 t4 = *(const f32x4*)(SBB + (size_t)e * 16 + q * 2); bbr[2 * q] = t4[0]; bbi[2 * q] = t4[1]; bbr[2 * q + 1] = t4[2]; bbi[2 * q + 1] = t4[3]; }
      const float2 x0 = E[(size_t)ci * 2048 + e];
      float xr = x0.x, xi = x0.y;
      const float* cre = p.in[15] + ((size_t)(((l * 2 + d) * 16 + g) * 16 + pp)) * 64;
      const float* cim = p.in[16] + ((size_t)(((l * 2 + d) * 16 + g) * 16 + pp)) * 64;
      for (int sb = 0; sb < 4; ++sb) {
#pragma unroll 1
        for (int k = 0; k < 8; ++k) {
          const int s = sb * 8 + k;
          const int t = d ? 31 - s : s;
          const u32x4 u0 = *(const u32x4*)(ub + t * 256 + g * 16), u1 = *(const u32x4*)(ub + t * 256 + g * 16 + 8);
          float uu[16]; unpack8(u0, uu); unpack8(u1, uu + 8);
          float br = 0.f, bi = 0.f;
#pragma unroll
          for (int q = 0; q < 16; ++q) { br += bbr[q] * uu[q]; bi += bbi[q] * uu[q]; }
          const float nx = a.x * xr - a.y * xi + br, ny = a.x * xi + a.y * xr + bi;
          xr = nx; xi = ny;
          sre[k * 68 + lane] = nx; sim[k * 68 + lane] = ny;
        }
        __syncthreads();
        float a0 = 0.f, a1 = 0.f;
#pragma unroll 2
        for (int n4 = 0; n4 < 16; ++n4) {
          const float4 cr4 = *(const float4*)(cre + n4 * 4), ci4 = *(const float4*)(cim + n4 * 4);
          const float4 r0 = *(const float4*)(sre + tsub * 68 + n4 * 4), i0 = *(const float4*)(sim + tsub * 68 + n4 * 4);
          const float4 r1 = *(const float4*)(sre + (tsub + 4) * 68 + n4 * 4), i1 = *(const float4*)(sim + (tsub + 4) * 68 + n4 * 4);
          a0 += cr4.x * r0.x + cr4.y * r0.y + cr4.z * r0.z + cr4.w * r0.w - (ci4.x * i0.x + ci4.y * i0.y + ci4.z * i0.z + ci4.w * i0.w);
          a1 += cr4.x * r1.x + cr4.y * r1.y + cr4.z * r1.z + cr4.w * r1.w - (ci4.x * i1.x + ci4.y * i1.y + ci4.z * i1.z + ci4.w * i1.w);
        }
        const int s0 = sb * 8 + tsub, s1 = s0 + 4;
        const int t0 = d ? 31 - s0 : s0, t1 = d ? 31 - s1 : s1;
        y[t0 * 256 + g * 16 + pp] += a0;
        y[t1 * 256 + g * 16 + pp] += a1;
        __syncthreads();
      }
    }
  }
  __syncthreads();
  const float* dsk = p.in[17] + l * 256;
#pragma unroll 4
  for (int i = 0; i < 32; ++i) {
    const int id = tid + 256 * i; const int t = id >> 8, col = id & 255;
    const float v = y[id] + dsk[col] * bf2f(ub[id]);
    RA[(size_t)(ci * 32 + t) * 2176 + col] = f2bf(geluf_(v));
  }
}

__device__ __forceinline__ void mla_prep_tile(const Params& p, int x, unsigned char* smem) {
  const int tid = get_tid();
  bfu* RA = (bfu*)(p.ws + OFF_RA);
  bfu* Qb = (bfu*)(p.ws + OFF_RC);
  bfu* Kb = Qb + (size_t)T * 384;
  bfu* Vb = Qb + (size_t)T * 768;
  const float* rc = (const float*)(p.ws + OFF_ROPE);
  const float* rs_ = rc + 8192 * 16;
  float* rinv = (float*)(smem + 67584);
  const float* Cs = (const float*)smem;
  int mt, j;
  if (x < 768) { mt = x / 3; j = x - mt * 3; } else { const int y = x - 768; mt = y >> 2; j = 3 + (y & 3); }
  const int m0 = mt * 128;
  int sstart, slen; seq_of_token(m0, sstart, slen);
  f32x4 acc[4][4]; zero_acc<4>(acc);
  if (j < 3) {
    gemm_main<4>(acc, RA + (size_t)m0 * 2176 + 1536, 2176, (const bfu*)(p.ws + OFF_WQUP) + (size_t)j * 128 * 192, 192, 192, smem);
    acc_to_lds<4>(acc, smem);
    {
      const int r = tid >> 1, hf = tid & 1;
      const bfu* a = RA + (size_t)(m0 + r) * 2176 + 1536 + hf * 96;
      float ss = 0.f;
#pragma unroll
      for (int c = 0; c < 12; ++c) { float f[8]; unpack8(*(const u32x4*)(a + c * 8), f);
#pragma unroll
        for (int e = 0; e < 8; ++e) ss += f[e] * f[e]; }
      ss += __shfl_xor(ss, 1);
      if (hf == 0) rinv[r] = rsqrtf(ss * (1.f / 192.f) + 1e-6f);
    }
    __syncthreads();
#pragma unroll
    for (int it = 0; it < 8; ++it) {
      const int cid = it * 256 + tid;
      const int r = cid >> 4, c = (cid & 15) * 8;
      const int n = j * 128 + c;
      const int gc = n >> 3; const int hcc = gc % 12;
      const float ri = rinv[r];
      const int pos = m0 + r - sstart;
      float o[8];
      const float* cs = Cs + r * 132 + c;
      if (hcc < 8) {
#pragma unroll
        for (int e = 0; e < 8; ++e) o[e] = cs[e] * ri;
      } else if (hcc < 10) {
        const int i0 = (hcc - 8) * 8;
#pragma unroll
        for (int e = 0; e < 8; ++e) { const float x1 = cs[e] * ri, x2 = cs[16 + e] * ri; o[e] = x1 * rc[pos * 16 + i0 + e] - x2 * rs_[pos * 16 + i0 + e]; }
      } else {
        const int i0 = (hcc - 10) * 8;
#pragma unroll
        for (int e = 0; e < 8; ++e) { const float x2 = cs[e] * ri, x1 = cs[e - 16] * ri; o[e] = x1 * rs_[pos * 16 + i0 + e] + x2 * rc[pos * 16 + i0 + e]; }
      }
      u32x4 st; st.x = pack2(o[0], o[1]); st.y = pack2(o[2], o[3]); st.z = pack2(o[4], o[5]); st.w = pack2(o[6], o[7]);
      *(u32x4*)(Qb + (size_t)(m0 + r) * 384 + n) = st;
    }
  } else {
    const int h = j - 3;
    gemm_main<4>(acc, RA + (size_t)m0 * 2176 + 1728, 2176, (const bfu*)(p.ws + OFF_WKVUP) + (size_t)h * 128 * 128, 128, 128, smem);
    acc_to_lds<4>(acc, smem);
    {
      const int r = tid >> 1, hf = tid & 1;
      const bfu* a = RA + (size_t)(m0 + r) * 2176 + 1728 + hf * 64;
      float ss = 0.f;
#pragma unroll
      for (int c = 0; c < 8; ++c) { float f[8]; unpack8(*(const u32x4*)(a + c * 8), f);
#pragma unroll
        for (int e = 0; e < 8; ++e) ss += f[e] * f[e]; }
      ss += __shfl_xor(ss, 1);
      if (hf == 0) rinv[r] = rsqrtf(ss * (1.f / 128.f) + 1e-6f);
    }
    __syncthreads();
#pragma unroll
    for (int it = 0; it < 8; ++it) {
      const int cid = it * 256 + tid;
      const int r = cid >> 4, c = (cid & 15) * 8;
      const float ri = rinv[r];
      const float* cs = Cs + r * 132 + c;
      u32x4 st; st.x = pack2(cs[0] * ri, cs[1] * ri); st.y = pack2(cs[2] * ri, cs[3] * ri); st.z = pack2(cs[4] * ri, cs[5] * ri); st.w = pack2(cs[6] * ri, cs[7] * ri);
      if (c < 64) *(u32x4*)(Kb + (size_t)(m0 + r) * 384 + h * 96 + c) = st;
    }
#pragma unroll
    for (int it = 0; it < 4; ++it) {
      const int cid = it * 256 + tid;
      const int dd = cid & 63, r0 = (cid >> 6) * 8;
      float v[8];
#pragma unroll
      for (int e = 0; e < 8; ++e) v[e] = Cs[(r0 + e) * 132 + 64 + dd] * rinv[r0 + e];
      u32x4 st; st.x = pack2(v[0], v[1]); st.y = pack2(v[2], v[3]); st.z = pack2(v[4], v[5]); st.w = pack2(v[6], v[7]);
      *(u32x4*)(Vb + (size_t)sstart * 256 + (size_t)(h * 64 + dd) * slen + (m0 - sstart) + r0) = st;
    }
#pragma unroll
    for (int it = 0; it < 2; ++it) {
      const int cid = it * 256 + tid;
      const int r = cid >> 2, ch = cid & 3;
      const int pos = m0 + r - sstart;
      const bfu* kr = RA + (size_t)(m0 + r) * 2176 + 1856;
      const int i0 = (ch & 1) * 8;
      float x1[8], x2[8], o[8];
      unpack8(*(const u32x4*)(kr + i0), x1);
      unpack8(*(const u32x4*)(kr + 16 + i0), x2);
#pragma unroll
      for (int e = 0; e < 8; ++e) {
        const float cc = rc[pos * 16 + i0 + e], sn = rs_[pos * 16 + i0 + e];
        o[e] = (ch < 2) ? (x1[e] * cc - x2[e] * sn) : (x1[e] * sn + x2[e] * cc);
      }
      u32x4 st; st.x = pack2(o[0], o[1]); st.y = pack2(o[2], o[3]); st.z = pack2(o[4], o[5]); st.w = pack2(o[6], o[7]);
      *(u32x4*)(Kb + (size_t)(m0 + r) * 384 + h * 96 + 64 + ch * 8) = st;
    }
  }
}

template <int D, int NQ, int MODE, bool VT>
__device__ __forceinline__ void attn_item(const bfu* Q, int ldq, const bfu* Kb, int ldk, const bfu* Vb, int ldv, bfu* O, int ldo,
                          int kt0, int kt1, float sc, float m_init, int q0pos, const float* tab, unsigned char* smem) {
  constexpr int DK = (D == 64) ? 80 : 112;
  constexpr int KC = 64 * D / 8 / 256;
  constexpr int DC = D / 8;
  const int tid = get_tid(), lane = tid & 63, wave = tid >> 6, fr = lane & 15, fq = lane >> 4;
  constexpr int KSZ = 64 * DK * 2, BUFSZ = KSZ + 64 * 72 * 2;
  bf16x8 qf[NQ][D / 32];
#pragma unroll
  for (int qs = 0; qs < NQ; ++qs)
#pragma unroll
    for (int kk = 0; kk < D / 32; ++kk)
      qf[qs][kk] = *(const bf16x8*)(Q + (size_t)(wave * 16 * NQ + qs * 16 + fr) * ldq + kk * 32 + fq * 8);
  f32x4 o[NQ][4];
  float m[NQ], ls[NQ];
#pragma unroll
  for (int qs = 0; qs < NQ; ++qs) {
    m[qs] = m_init; ls[qs] = (MODE == 1 && fq == 0) ? 1.f : 0.f;
#pragma unroll
    for (int dt = 0; dt < 4; ++dt) o[qs][dt] = f32x4{0.f, 0.f, 0.f, 0.f};
  }
  u32x4 kr[KC], vr[2];
  auto load_tile = [&](int kt) {
#pragma unroll
    for (int i = 0; i < KC; ++i) { const int id = tid + 256 * i; const int row = id / DC, c = id - row * DC; kr[i] = *(const u32x4*)(Kb + (size_t)(kt * 64 + row) * ldk + c * 8); }
#pragma unroll
    for (int i = 0; i < 2; ++i) {
      const int id = tid + 256 * i; const int key = id >> 3, dc = id & 7;
      if (VT) vr[i] = *(const u32x4*)(Vb + (size_t)key * ldv + kt * 64 + dc * 8);
      else vr[i] = *(const u32x4*)(Vb + (size_t)(kt * 64 + key) * ldv + dc * 8);
    }
  };
  auto write_tile = [&](int buf) {
    bfu* Ks = (bfu*)(smem + buf * BUFSZ);
    bfu* Vt = (bfu*)(smem + buf * BUFSZ + KSZ);
#pragma unroll
    for (int i = 0; i < KC; ++i) { const int id = tid + 256 * i; const int row = id / DC, c = id - row * DC; *(u32x4*)(Ks + row * DK + c * 8) = kr[i]; }
#pragma unroll
    for (int i = 0; i < 2; ++i) {
      const int id = tid + 256 * i; const int key = id >> 3, dc = id & 7;
      if (VT) {
        *(u32x4*)(Vt + key * 72 + dc * 8) = vr[i];
      } else {
#pragma unroll
        for (int e = 0; e < 4; ++e) {
          Vt[(dc * 8 + 2 * e) * 72 + key] = (bfu)(vr[i][e] & 0xFFFFu);
          Vt[(dc * 8 + 2 * e + 1) * 72 + key] = (bfu)(vr[i][e] >> 16);
        }
      }
    }
  };
  load_tile(kt0);
  __syncthreads();
  write_tile(0);
  load_tile(min(kt0 + 1, kt1 - 1));
  __syncthreads();
  for (int kt = kt0; kt < kt1; ++kt) {
    const int cur = (kt - kt0) & 1;
    write_tile(cur ^ 1);
    load_tile(min(kt + 2, kt1 - 1));
    __builtin_amdgcn_sched_barrier(0);
    const bfu* Ks = (const bfu*)(smem + cur * BUFSZ);
    const bfu* Vt = (const bfu*)(smem + cur * BUFSZ + KSZ);
    f32x4 s[NQ][4];
#pragma unroll
    for (int qs = 0; qs < NQ; ++qs)
#pragma unroll
      for (int st = 0; st < 4; ++st) s[qs][st] = f32x4{0.f, 0.f, 0.f, 0.f};
#pragma unroll
    for (int qs = 0; qs < NQ; ++qs)
#pragma unroll
      for (int st = 0; st < 4; ++st)
#pragma unroll
        for (int kk = 0; kk < D / 32; ++kk) {
          const bf16x8 a = *(const bf16x8*)(Ks + (st * 16 + fr) * DK + kk * 32 + fq * 8);
          s[qs][st] = __builtin_amdgcn_mfma_f32_16x16x32_bf16(a, qf[qs][kk], s[qs][st], 0, 0, 0);
        }
    bf16x8 pf[NQ][2];
#pragma unroll
    for (int qs = 0; qs < NQ; ++qs) {
      const int qi = wave * 16 * NQ + qs * 16 + fr;
      float mloc = -INFINITY;
#pragma unroll
      for (int st = 0; st < 4; ++st)
#pragma unroll
        for (int j = 0; j < 4; ++j) {
          const int key = st * 16 + fq * 4 + j;
          float t = (MODE == 0) ? s[qs][st][j] : s[qs][st][j] * sc;
          if (MODE == 1) {
            const int rel = kt * 64 + key - (q0pos + qi);
            const bool valid = (rel >= -128) && (rel <= 128);
            const int ri = min(max(rel + 128, 0), 256);
            t = valid ? t + tab[ri] : -1e30f;
          } else if (MODE == 2) {
            const int c = qi;
            const int cs = min(max(c - 8, 0), 48);
            const bool valid = (key >= cs) && (key < cs + 16);
            const int dr = kt - (q0pos >> 6) + 7;
            const int dc = min(max(key - c + 15, 0), 30);
            t = valid ? t + tab[dr * 31 + dc] : -1e30f;
          }
          s[qs][st][j] = t;
          mloc = fmaxf(mloc, t);
        }
      mloc = fmaxf(mloc, __shfl_xor(mloc, 16));
      mloc = fmaxf(mloc, __shfl_xor(mloc, 32));
      if (MODE == 0) mloc *= sc;
      const float mn = fmaxf(m[qs], mloc);
      const float alpha = __builtin_amdgcn_exp2f(m[qs] - mn);
      m[qs] = mn;
      float psum = 0.f;
#pragma unroll
      for (int st = 0; st < 4; ++st)
#pragma unroll
        for (int j = 0; j < 4; ++j) {
          const float pv = __builtin_amdgcn_exp2f((MODE == 0) ? __builtin_fmaf(s[qs][st][j], sc, -mn) : s[qs][st][j] - mn);
          psum += pv; s[qs][st][j] = pv;
        }
      ls[qs] = ls[qs] * alpha + psum;
#pragma unroll
      for (int dt = 0; dt < 4; ++dt)
#pragma unroll
        for (int j = 0; j < 4; ++j) o[qs][dt][j] *= alpha;
#pragma unroll
      for (int k2 = 0; k2 < 2; ++k2) {
        union { bf16x8 v; u32x4 u; } pk;
        pk.u = u32x4{pack2(s[qs][2 * k2][0], s[qs][2 * k2][1]), pack2(s[qs][2 * k2][2], s[qs][2 * k2][3]),
                     pack2(s[qs][2 * k2 + 1][0], s[qs][2 * k2 + 1][1]), pack2(s[qs][2 * k2 + 1][2], s[qs][2 * k2 + 1][3])};
        pf[qs][k2] = pk.v;
      }
#pragma unroll
      for (int dt = 0; dt < 4; ++dt)
#pragma unroll
        for (int k2 = 0; k2 < 2; ++k2) {
          const u32x2 h0 = *(const u32x2*)(Vt + (dt * 16 + fr) * 72 + k2 * 32 + fq * 4);
          const u32x2 h1 = *(const u32x2*)(Vt + (dt * 16 + fr) * 72 + k2 * 32 + 16 + fq * 4);
          union { bf16x8 v; u32x4 u; } av;
          av.u = u32x4{h0[0], h0[1], h1[0], h1[1]};
          o[qs][dt] = __builtin_amdgcn_mfma_f32_16x16x32_bf16(av.v, pf[qs][k2], o[qs][dt], 0, 0, 0);
        }
    }
    __syncthreads();
  }
#pragma unroll
  for (int qs = 0; qs < NQ; ++qs) {
    float l = ls[qs];
    l += __shfl_xor(l, 16);
    l += __shfl_xor(l, 32);
    const float inv = __builtin_amdgcn_rcpf(l);
    const int qi = wave * 16 * NQ + qs * 16 + fr;
#pragma unroll
    for (int dt = 0; dt < 4; ++dt) {
      u32x2 st; st.x = pack2(o[qs][dt][0] * inv, o[qs][dt][1] * inv); st.y = pack2(o[qs][dt][2] * inv, o[qs][dt][3] * inv);
      *(u32x2*)(O + (size_t)qi * ldo + dt * 16 + fq * 4) = st;
    }
  }
}

constexpr int ATT_TAB_OFF = 2 * (64 * 112 * 2 + 64 * 72 * 2);

__device__ __forceinline__ void swa_item(const Params& p, int l, int x, unsigned char* smem) {
  const int gt = x >> 2, h = x & 3;
  const int t0 = gt * 128;
  int sstart, slen; seq_of_token(t0, sstart, slen);
  const int q0 = t0 - sstart; const int qt = q0 >> 7;
  float* tab = (float*)(smem + ATT_TAB_OFF);
  __syncthreads();
  for (int i = get_tid(); i < 257; i += 256) tab[i] = ((const float*)(p.ws + OFF_T5))[h * 257 + i];
  bfu* RA = (bfu*)(p.ws + OFF_RA);
  const int kt0 = max(0, qt * 2 - 2), kt1 = min(slen >> 6, qt * 2 + 4);
  const float sink = p.in[19][l * 4 + h] * LOG2E;
  attn_item<64, 2, 1, false>(RA + (size_t)t0 * 2176 + 256 + h * 64, 2176,
                      RA + (size_t)sstart * 2176 + 512 + (h >> 1) * 64, 2176,
                      RA + (size_t)sstart * 2176 + 640 + (h >> 1) * 64, 2176,
                      RA + (size_t)t0 * 2176 + 256 + h * 64, 2176, kt0, kt1, 0.125f * LOG2E, sink, q0, tab, smem);
}
__device__ __forceinline__ void na_item(const Params& p, int l, int x, unsigned char* smem) {
  const int gt = x >> 2, h = x & 3;
  const int t0 = gt * 64;
  int sstart, slen; seq_of_token(t0, sstart, slen);
  const int q0 = t0 - sstart; const int r = q0 >> 6; const int rows = slen >> 6;
  const int rs = min(max(r - 4, 0), rows - 8);
  float* tab = (float*)(smem + ATT_TAB_OFF);
  __syncthreads();
  for (int i = get_tid(); i < 465; i += 256) tab[i] = p.in[21][(size_t)(l * 4 + h) * 465 + i] * LOG2E;
  bfu* RA = (bfu*)(p.ws + OFF_RA);
  attn_item<64, 1, 2, false>(RA + (size_t)t0 * 2176 + 768 + h * 64, 2176,
                      RA + (size_t)sstart * 2176 + 1024 + h * 64, 2176,
                      RA + (size_t)sstart * 2176 + 1280 + h * 64, 2176,
                      RA + (size_t)t0 * 2176 + 768 + h * 64, 2176, rs, rs + 8, 0.125f * LOG2E, -INFINITY, q0, tab, smem);
}
__device__ __forceinline__ void memattn_item(const Params& p, int x, unsigned char* smem) {
  const int gt = x >> 2, h = x & 3;
  const int t0 = gt * 128;
  const int seq = (t0 < 16384) ? (t0 >> 13) : (2 + ((t0 - 16384) >> 12));
  bfu* RA = (bfu*)(p.ws + OFF_RA);
  const bfu* MKV = (const bfu*)(p.ws + OFF_MEMKV) + (size_t)seq * 256 * 512;
  attn_item<64, 2, 0, false>(RA + (size_t)t0 * 2176 + 1888 + h * 64, 2176, MKV + h * 64, 512, MKV + 256 + h * 64, 512,
                      RA + (size_t)t0 * 2176 + 1888 + h * 64, 2176, 0, 4, 0.125f * LOG2E, -INFINITY, 0, nullptr, smem);
}
__device__ __forceinline__ void mla_item(const Params& p, int x, unsigned char* smem) {
  const int gt = x >> 2, h = x & 3;
  const int t0 = gt * 128;
  int sstart, slen; seq_of_token(t0, sstart, slen);
  const bfu* Qb = (const bfu*)(p.ws + OFF_RC);
  const bfu* Kb = Qb + (size_t)T * 384;
  const bfu* Vb = Qb + (size_t)T * 768;
  bfu* RA = (bfu*)(p.ws + OFF_RA);
  attn_item<96, 2, 0, true>(Qb + (size_t)t0 * 384 + h * 96, 384, Kb + (size_t)sstart * 384 + h * 96, 384, Vb + (size_t)sstart * 256 + (size_t)h * 64 * slen, slen,
                      RA + (size_t)t0 * 2176 + 1536 + h * 64, 2176, 0, slen >> 6, 0.10206207261596575f * LOG2E, -INFINITY, 0, nullptr, smem);
}

__device__ __forceinline__ void glu_item(const Params& p, int x, unsigned char* smem) {
  bfu* RA = (bfu*)(p.ws + OFF_RA);
  const bfu* W = (const bfu*)(p.ws + OFF_WGLU);
  const int mt = x >> 1, nt = x & 1;
  bfu* rows = RA + (size_t)mt * 128 * 2176;
  f32x4 acc[4][4];
  zero_acc<4>(acc);
  gemm_main<4>(acc, rows, 2176, W + (size_t)nt * 128 * 256, 256, 256, smem);
  acc_to_lds<4>(acc, smem);
  const float* Cs = (const float*)smem;
#pragma unroll
  for (int it = 0; it < 8; ++it) {
    const int cid = it * 256 + get_tid();
    const int r = cid >> 4, c = (cid & 15) * 8;
    const bfu* gp = rows + (size_t)r * 2176 + nt * 128 + c;
    float g[8]; unpack8(*(const u32x4*)gp, g);
    const float* cs = Cs + r * 132 + c;
    float o[8];
#pragma unroll
    for (int e = 0; e < 8; ++e) o[e] = g[e] * sigmoidf_(cs[e]);
    u32x4 st; st.x = pack2(o[0], o[1]); st.y = pack2(o[2], o[3]); st.z = pack2(o[4], o[5]); st.w = pack2(o[6], o[7]);
    *(u32x4*)(rows + (size_t)r * 2176 + 512 + nt * 128 + c) = st;
  }
}

__device__ __forceinline__ void phase_merge(const Params& p, unsigned char* smem) {
  constexpr int ASZ = 256 * 64, BSZ = 128 * 64, STG = ASZ + BSZ;
  constexpr int NS = 200;
  const bfu* XN = (const bfu*)(p.ws + OFF_XN);
  const bfu* RA = (const bfu*)(p.ws + OFF_RA);
  const bfu* WG = (const bfu*)(p.ws + OFF_WING);
  const bfu* WB = (const bfu*)(p.ws + OFF_WBR);
  bfu* MG = (bfu*)(p.ws + OFF_RC);
  const int Mt = T / 256, Nt = 8;
  FOR_TILES(id, Mt * Nt) {
    int mt, nt; tile_mn(id, Mt, Nt, mt, nt);
    const int tid = get_tid512(), lane = tid & 63, wave = tid >> 6, fr = lane & 15, fq = lane >> 4, wm = wave >> 1, wn = wave & 1;
    const int lrow = lane >> 2;
    const int lchunk = (lane & 3) ^ ((lane >> 4) & 2);
    const int rd_off = fr * 64 + ((fq ^ ((fr >> 2) & 2)) << 4);
    const unsigned arow = (unsigned)(mt * 256 + wave * 32 + lrow);
    const unsigned brow = (unsigned)(nt * 128 + wave * 16 + lrow);
    const unsigned aoX = arow * 1024u + lchunk * 8, aoR = arow * 2176u + lchunk * 8, boG = brow * 1024u + lchunk * 8, boB = brow * 256u + lchunk * 8;
    f32x4 accO[4][4], acc[4][4];
    u32x4* gpl = (u32x4*)(smem + 73728) + tid;
#pragma unroll
    for (int mi = 0; mi < 4; ++mi)
#pragma unroll
      for (int ni = 0; ni < 4; ++ni) { accO[mi][ni] = f32x4{0.f, 0.f, 0.f, 0.f}; acc[mi][ni] = f32x4{0.f, 0.f, 0.f, 0.f}; }
    asm volatile("s_waitcnt vmcnt(0)" ::: "memory");
    __syncthreads();
#define MG_ISSUE(s_, stg_)                                                                                                        \
    {                                                                                                                               \
      const int bb_ = (s_) / 40, rr_ = (s_) - bb_ * 40;                                                                             \
      const bool gate_ = rr_ < 32;                                                                                                  \
      const int kk_ = gate_ ? rr_ : rr_ - 32;                                                                                       \
      const int coff_ = (bb_ == 0) ? 512 : (bb_ == 1) ? 256 : (bb_ == 2) ? 768 : (bb_ == 3) ? 1536 : 1888;                           \
      const bfu* ap_ = gate_ ? (XN + kk_ * 32) + aoX : (RA + coff_ + kk_ * 32) + aoR;                                                \
      const unsigned as_ = gate_ ? 16u * 1024u : 16u * 2176u;                                                                         \
      const bfu* bp_ = gate_ ? (WG + (size_t)bb_ * 1024 * 1024 + kk_ * 32) + boG : (WB + (size_t)bb_ * 1024 * 256 + kk_ * 32) + boB;  \
      unsigned char* sb_ = smem + (stg_) * STG;                                                                                     \
      __builtin_amdgcn_global_load_lds((const unsigned*)ap_, (__attribute__((address_space(3))) unsigned*)(sb_ + (wave * 32) * 64), 16, 0, 0);           \
      __builtin_amdgcn_global_load_lds((const unsigned*)(ap_ + as_), (__attribute__((address_space(3))) unsigned*)(sb_ + (wave * 32 + 16) * 64), 16, 0, 0); \
      __builtin_amdgcn_global_load_lds((const unsigned*)bp_, (__attribute__((address_space(3))) unsigned*)(sb_ + ASZ + (wave * 16) * 64), 16, 0, 0);      \
    }
    MG_ISSUE(0, 0);
    MG_ISSUE(1, 1);
    int stg = 0, sidx = 0;
#define MG_STEP()                                                                                          \
    {                                                                                                        \
      if (sidx + 1 < NS) asm volatile("s_waitcnt vmcnt(3)" ::: "memory");                                    \
      else asm volatile("s_waitcnt vmcnt(0)" ::: "memory");                                                  \
      asm volatile("s_waitcnt lgkmcnt(0)" ::: "memory");                                                     \
      __builtin_amdgcn_s_barrier();                                                                          \
      if (sidx + 2 < NS) {                                                                                   \
        const int s2 = (stg >= 1) ? stg - 1 : 2;                                                             \
        MG_ISSUE(sidx + 2, s2);                                                                              \
      }                                                                                                      \
      const unsigned char* Ac = smem + stg * STG + rd_off;                                                   \
      const unsigned char* Bc = Ac + ASZ;                                                                    \
      bf16x8 bfv[4];                                                                                         \
      _Pragma("unroll") for (int ni = 0; ni < 4; ++ni) bfv[ni] = *(const bf16x8*)(Bc + (wn * 64 + ni * 16) * 64); \
      _Pragma("unroll") for (int mi = 0; mi < 4; ++mi) {                                                     \
        const bf16x8 a0 = *(const bf16x8*)(Ac + (wm * 64 + mi * 16) * 64);                                   \
        _Pragma("unroll") for (int ni = 0; ni < 4; ++ni)                                                     \
          acc[mi][ni] = __builtin_amdgcn_mfma_f32_16x16x32_bf16(a0, bfv[ni], acc[mi][ni], 0, 0, 0);          \
      }                                                                                                      \
      stg = (stg == 2) ? 0 : stg + 1;                                                                        \
      ++sidx;                                                                                                \
    }
#pragma unroll 1
    for (int b = 0; b < 5; ++b) {
#pragma unroll 1
      for (int k = 0; k < 32; ++k) MG_STEP()
#pragma unroll
      for (int mi = 0; mi < 4; ++mi)
#pragma unroll
        for (int nh = 0; nh < 2; ++nh) {
          u32x4 g4;
          g4.x = pack2(sigmoidf_(acc[mi][2 * nh][0]), sigmoidf_(acc[mi][2 * nh][1]));
          g4.y = pack2(sigmoidf_(acc[mi][2 * nh][2]), sigmoidf_(acc[mi][2 * nh][3]));
          g4.z = pack2(sigmoidf_(acc[mi][2 * nh + 1][0]), sigmoidf_(acc[mi][2 * nh + 1][1]));
          g4.w = pack2(sigmoidf_(acc[mi][2 * nh + 1][2]), sigmoidf_(acc[mi][2 * nh + 1][3]));
          gpl[(mi * 2 + nh) * 512] = g4;
          acc[mi][2 * nh] = f32x4{0.f, 0.f, 0.f, 0.f}; acc[mi][2 * nh + 1] = f32x4{0.f, 0.f, 0.f, 0.f};
        }
#pragma unroll 1
      for (int k = 0; k < 8; ++k) MG_STEP()
#pragma unroll
      for (int mi = 0; mi < 4; ++mi)
#pragma unroll
        for (int nh = 0; nh < 2; ++nh) {
          const u32x4 g4 = gpl[(mi * 2 + nh) * 512];
          accO[mi][2 * nh][0] += bflo(g4.x) * acc[mi][2 * nh][0];
          accO[mi][2 * nh][1] += bfhi(g4.x) * acc[mi][2 * nh][1];
          accO[mi][2 * nh][2] += bflo(g4.y) * acc[mi][2 * nh][2];
          accO[mi][2 * nh][3] += bfhi(g4.y) * acc[mi][2 * nh][3];
          accO[mi][2 * nh + 1][0] += bflo(g4.z) * acc[mi][2 * nh + 1][0];
          accO[mi][2 * nh + 1][1] += bfhi(g4.z) * acc[mi][2 * nh + 1][1];
          accO[mi][2 * nh + 1][2] += bflo(g4.w) * acc[mi][2 * nh + 1][2];
          accO[mi][2 * nh + 1][3] += bfhi(g4.w) * acc[mi][2 * nh + 1][3];
          acc[mi][2 * nh] = f32x4{0.f, 0.f, 0.f, 0.f}; acc[mi][2 * nh + 1] = f32x4{0.f, 0.f, 0.f, 0.f};
        }
    }
#undef MG_STEP
#undef MG_ISSUE
    __syncthreads();
    float* Cs = (float*)smem;
#pragma unroll
    for (int mi = 0; mi < 4; ++mi)
#pragma unroll
      for (int ni = 0; ni < 4; ++ni)
#pragma unroll
        for (int j = 0; j < 4; ++j) Cs[(wm * 64 + mi * 16 + fq * 4 + j) * 132 + wn * 64 + ni * 16 + fr] = accO[mi][ni][j];
    __syncthreads();
#pragma unroll
    for (int it = 0; it < 8; ++it) {
      const int cid = it * 512 + tid;
      const int r = cid >> 4, c = (cid & 15) * 8;
      const float* cs = Cs + r * 132 + c;
      u32x4 st; st.x = pack2(cs[0], cs[1]); st.y = pack2(cs[2], cs[3]); st.z = pack2(cs[4], cs[5]); st.w = pack2(cs[6], cs[7]);
      *(u32x4*)(MG + (size_t)(mt * 256 + r) * 1024 + nt * 128 + c) = st;
    }
  }
}

constexpr int NPH = 14;

template <int ph>
__device__ __forceinline__ void run_phase(const Params& p, int l, unsigned char* smem_raw) {
  unsigned char* smem = smem_raw + vb_id() * LDS_HALF;
  switch (ph) {
    case 0: phase_prep(p, l, smem); break;
    case 1: phase_ffn_gu(p, 0, smem_raw); break;
    case 2: phase_resid_gemm(p, (const bfu*)(p.ws + OFF_RA), 2816, 2816, (const bfu*)(p.ws + OFF_WD1), 0.5f, smem_raw); break;
    case 3:
      for (int w = VBLK; w < T / 4; w += VGRID) norm_rows_phase(p, p.in[8] + l * 1024, 0, w);
      break;
    case 4: phase_inproj(p, smem_raw); break;
    case 5: {
      const int n1 = (T / 128) * 7, n2 = 256;
      for (int w = VBLK; w < n1 + n2; w += VGRID) {
        if (w < n1) mla_prep_tile(p, w, smem); else s5a_gemm_item(p, w - n1, smem);
      }
    } break;
    case 6: {
      const int nmla = 1024, nb = 48, nswa = 1024, nna = 2048, nmem = 1024;
      for (int w = VBLK; w < nmla + nb + nswa + nna + nmem; w += VGRID) {
        int x = w;
        if (x < nmla) { mla_item(p, x, smem); continue; }
        x -= nmla;
        if (x < nb) { s5b_item(p, x); continue; }
        x -= nb;
        if (x < nswa) { swa_item(p, l, x, smem); continue; }
        x -= nswa;
        if (x < nna) { na_item(p, l, x, smem); continue; }
        x -= nna;
        memattn_item(p, x, smem);
      }
    } break;
    case 7: break;
    case 15:
      for (int w = VBLK; w < 1024; w += VGRID) s5_item<true>(p, l, w, smem);
      break;
    case 8:
      for (int w = VBLK; w < T / 64; w += VGRID) glu_item(p, w, smem);
      break;
    case 9: phase_merge(p, smem_raw); break;
    case 10: phase_resid_gemm(p, (const bfu*)(p.ws + OFF_RC), 1024, 1024, (const bfu*)(p.ws + OFF_WOUT), 1.0f, smem_raw); break;
    case 11:
      for (int w = VBLK; w < T / 4; w += VGRID) norm_rows_phase(p, p.in[30] + l * 1024, 0, w);
      break;
    case 12: phase_ffn_gu(p, 1, smem_raw); break;
    case 13: phase_resid_gemm(p, (const bfu*)(p.ws + OFF_RA), 2816, 2816, (const bfu*)(p.ws + OFF_WD2), 0.5f, smem_raw); break;
    default: {
      for (int w = VBLK; w < T / 4; w += VGRID) {
        const int row = w * 4 + (get_tid() >> 6);
        float* hp = p.out + (size_t)row * 1024;
        rms_row(hp, p.in[34], nullptr, nullptr, hp);
      }
    } break;
  }
}

#if MEGA
__device__ __forceinline__ void gbar(unsigned* ctr, unsigned target) {
  __syncthreads();
  if (threadIdx.x == 0) {
    __builtin_amdgcn_fence(__ATOMIC_RELEASE, "agent");
    __hip_atomic_fetch_add(ctr, 1u, __ATOMIC_RELAXED, __HIP_MEMORY_SCOPE_AGENT);
    while (__hip_atomic_load(ctr, __ATOMIC_RELAXED, __HIP_MEMORY_SCOPE_AGENT) < target) __builtin_amdgcn_s_sleep(2);
    __builtin_amdgcn_fence(__ATOMIC_ACQUIRE, "agent");
  }
  __syncthreads();
}
__global__ void __launch_bounds__(512, 2) k_mega(Params p) {
  extern __shared__ __attribute__((aligned(16))) unsigned char smem[];
  cg::grid_group grid = cg::this_grid();
  unsigned nbar = 0;
  unsigned* bar_ctr = (unsigned*)(p.ws + OFF_BAR);
  {
    constexpr int l = 0;
#define PHS1(k) { const Params* pp = (const Params*)__builtin_amdgcn_kernarg_segment_ptr(); asm volatile("" : "+s"(pp)); const Params q = *pp; run_phase<k>(q, l, smem); } if (nbar == 0) { grid.sync(); nbar = 1; } else { gbar(bar_ctr, nbar * gridDim.x); ++nbar; }
#define PHS(k) PHS1(k) if (k == PROBE_PH) { _Pragma("unroll 1") for (int rep = 0; rep < PROBE_N; ++rep) { PHS1(k) } }
    PHS(0) PHS(1) PHS(2) PHS(3) PHS(4) PHS(5) PHS(6) PHS(15) PHS(8) PHS(9) PHS(10) PHS(11) PHS(12) PHS(13)
  }
  {
    constexpr int l = 1;
    PHS(0) PHS(1) PHS(2) PHS(3) PHS(4) PHS(5) PHS(6) PHS(15) PHS(8) PHS(9) PHS(10) PHS(11) PHS(12) PHS(13)
#undef PHS
  }
  { const Params* pp = (const Params*)__builtin_amdgcn_kernarg_segment_ptr(); asm volatile("" : "+s"(pp)); const Params q = *pp; run_phase<NPH>(q, 0, smem); }
}

#endif

template <int PH>
__global__ void __launch_bounds__(512, 2) k_phase(Params p, int l) {
  extern __shared__ __attribute__((aligned(16))) unsigned char smem[];
  run_phase<PH>(p, l, smem);
}
template <int PH>
static void launch_phase(const Params& p, int l, int grid, hipStream_t stream) {
  static bool attr = false;
  if (!attr) { hipFuncSetAttribute((const void*)k_phase<PH>, hipFuncAttributeMaxDynamicSharedMemorySize, LDS_BYTES); attr = true; }
  hipLaunchKernelGGL(k_phase<PH>, dim3(grid), dim3(512), LDS_BYTES, stream, p, l);
}

extern "C" void kernel_launch(void* const* d_in, const int* in_sizes, int n_in, void* d_out, int out_size, void* d_ws,
                              size_t ws_size, hipStream_t stream) {
  static int grid_blocks = 0;
  if (!grid_blocks) {
    int dev = 0, cus = 0, per_cu = 0;
    hipGetDevice(&dev);
    hipDeviceGetAttribute(&cus, hipDeviceAttributeMultiprocessorCount, dev);
#if MEGA
    hipFuncSetAttribute((const void*)k_mega, hipFuncAttributeMaxDynamicSharedMemorySize, LDS_BYTES);
    hipOccupancyMaxActiveBlocksPerMultiprocessor(&per_cu, k_mega, 512, LDS_BYTES);
#else
    per_cu = 1;
#endif
    per_cu = 1;
    if (cus <= 0) cus = 256;
    grid_blocks = cus * per_cu;
    if (ws_size < WS_END) fprintf(stderr, "kernel_launch: workspace too small: %zu < %zu\n", ws_size, (size_t)WS_END);
  }
  Params p{};
  for (int i = 0; i < 35; ++i) p.in[i] = (const float*)d_in[i];
  p.out = (float*)d_out;
  p.ws = (unsigned char*)d_ws;
#if MEGA
  hipMemsetAsync((char*)d_ws + OFF_BAR, 0, 256, stream);
  void* args[] = {&p};
  hipError_t e = hipLaunchCooperativeKernel((void*)k_mega, dim3(grid_blocks), dim3(512), args, LDS_BYTES, stream);
  if (e != hipSuccess) fprintf(stderr, "cooperative launch failed: %s (grid %d)\n", hipGetErrorString(e), grid_blocks);
#else
  for (int l = 0; l < 2; ++l) {
#define LP(k) launch_phase<k>(p, l, grid_blocks, stream);
    LP(0) LP(1) LP(2) LP(3) LP(4) LP(5) LP(6) LP(15) LP(8) LP(9) LP(10) LP(11) LP(12) LP(13)
#undef LP
  }
  launch_phase<NPH>(p, 0, grid_blocks, stream);
#endif
}
```
